# Optimizing an MI355X kernel written in HIP

```python
import jax, jax.numpy as jnp
from jax import lax
import numpy as np

D_MODEL = 1024
BATCH = 1
SEQ = 16384
DEPTH = 4

N_MIXERS = 2
N_MLA = (DEPTH + 1) // 2
N_GLA = DEPTH // 2

MLA_HEADS = 8
QK_NOPE = 128
QK_ROPE = 64
V_HEAD = 128
Q_LORA = 384
KV_LORA = 256
ROPE_THETA = 10000.0
Q_BLOCK = 128

GLA_HEADS = 4
GLA_DK = D_MODEL // 2
GLA_DV = D_MODEL
GLA_HEAD_K = GLA_DK // GLA_HEADS
GLA_HEAD_V = GLA_DV // GLA_HEADS
GATE_RANK = 16
GATE_NORMALIZER = 16.0
CHUNK = 64

D_FF = 4 * D_MODEL
EPS = 1e-6

kernel_name = "hybrid_mla_gla_sqrelu_trunk"


def rms_norm(x, gain):
    xf = x.astype(jnp.float32)
    y = xf * lax.rsqrt(jnp.mean(xf * xf, axis=-1, keepdims=True) + EPS)
    return (y * gain.astype(jnp.float32)).astype(x.dtype)


def rope_tables(positions):
    inv_freq = 1.0 / (ROPE_THETA ** (jnp.arange(0, QK_ROPE, 2, dtype=jnp.float32) / QK_ROPE))
    ang = positions.astype(jnp.float32)[..., None] * inv_freq
    return jnp.cos(ang), jnp.sin(ang)


def apply_rope(t, cos, sin):
    tf = t.astype(jnp.float32)
    half = QK_ROPE // 2
    t1, t2 = tf[..., :half], tf[..., half:]
    out = jnp.concatenate([t1 * cos - t2 * sin, t2 * cos + t1 * sin], axis=-1)
    return out.astype(t.dtype)


def mla_mixer(xn, positions, w_in, q_norm, w_uq, kv_norm, w_ukv, w_o):
    B, S, _ = xn.shape
    h = xn @ w_in
    c_q = h[..., :Q_LORA]
    c_kv = h[..., Q_LORA:Q_LORA + KV_LORA]
    k_rope = h[..., Q_LORA + KV_LORA:]
    q = (rms_norm(c_q, q_norm) @ w_uq).reshape(B, S, MLA_HEADS, QK_NOPE + QK_ROPE)
    kv = (rms_norm(c_kv, kv_norm) @ w_ukv).reshape(B, S, MLA_HEADS, QK_NOPE + V_HEAD)
    q_nope, q_rope = q[..., :QK_NOPE], q[..., QK_NOPE:]
    k_nope, v = kv[..., :QK_NOPE], kv[..., QK_NOPE:]
    cos, sin = rope_tables(positions)
    q_rope = apply_rope(q_rope, cos[:, :, None, :], sin[:, :, None, :])
    k_rope = apply_rope(k_rope, cos, sin)
    scale = (QK_NOPE + QK_ROPE) ** -0.5
    n_blocks = S // Q_BLOCK
    qn_b = q_nope.reshape(B, n_blocks, Q_BLOCK, MLA_HEADS, QK_NOPE).transpose(1, 0, 2, 3, 4)
    qr_b = q_rope.reshape(B, n_blocks, Q_BLOCK, MLA_HEADS, QK_ROPE).transpose(1, 0, 2, 3, 4)
    key_idx = jnp.arange(S)

    def attend_block(args):
        qn, qr, blk = args
        s = (jnp.einsum('bqhd,bkhd->bhqk', qn, k_nope).astype(jnp.float32)
             + jnp.einsum('bqhd,bkd->bhqk', qr, k_rope).astype(jnp.float32)) * scale
        q_idx = blk * Q_BLOCK + jnp.arange(Q_BLOCK)
        mask = key_idx[None, :] <= q_idx[:, None]
        s = jnp.where(mask, s, -jnp.inf)
        p = jax.nn.softmax(s, axis=-1).astype(v.dtype)
        return jnp.einsum('bhqk,bkhd->bqhd', p, v)

    o = lax.map(attend_block, (qn_b, qr_b, jnp.arange(n_blocks)))
    o = o.transpose(1, 0, 2, 3, 4).reshape(B, S, MLA_HEADS * V_HEAD)
    return o @ w_o


def gla_mixer(xn, w_in, w_gk_up, b_gk, g_norm, w_o):
    B, S, _ = xn.shape
    h = xn @ w_in
    q = h[..., :GLA_DK]
    k = h[..., GLA_DK:2 * GLA_DK]
    v = h[..., 2 * GLA_DK:2 * GLA_DK + GLA_DV]
    g = h[..., 2 * GLA_DK + GLA_DV:2 * GLA_DK + 2 * GLA_DV]
    a = h[..., 2 * GLA_DK + 2 * GLA_DV:]
    gk = jax.nn.log_sigmoid((a @ w_gk_up + b_gk).astype(jnp.float32)) / GATE_NORMALIZER
    nc = S // CHUNK

    def to_chunks(t, d):
        return t.astype(jnp.float32).reshape(B, nc, CHUNK, GLA_HEADS, d).transpose(1, 0, 3, 2, 4)

    qc = to_chunks(q, GLA_HEAD_K) * (GLA_HEAD_K ** -0.5)
    kc = to_chunks(k, GLA_HEAD_K)
    vc = to_chunks(v, GLA_HEAD_V)
    bc = jnp.cumsum(to_chunks(gk, GLA_HEAD_K), axis=3)
    causal = jnp.tril(jnp.ones((CHUNK, CHUNK), dtype=bool))

    def step(state, inp):
        q_, k_, v_, b_ = inp
        o_inter = jnp.einsum('bhcd,bhde->bhce', q_ * jnp.exp(b_), state)
        diff = b_[:, :, :, None, :] - b_[:, :, None, :, :]
        decay = jnp.exp(jnp.where(causal[:, :, None], diff, -jnp.inf))
        attn = jnp.einsum('bhtd,bhsd,bhtsd->bhts', q_, k_, decay)
        o_intra = jnp.einsum('bhts,bhse->bhte', attn, v_)
        b_last = b_[:, :, -1:, :]
        new_state = (state * jnp.exp(b_last[:, :, 0, :, None])
                     + jnp.einsum('bhsd,bhse->bhde', k_ * jnp.exp(b_last - b_), v_))
        return new_state, o_inter + o_intra

    state0 = jnp.zeros((B, GLA_HEADS, GLA_HEAD_K, GLA_HEAD_V), jnp.float32)
    _, o = lax.scan(step, state0, (qc, kc, vc, bc))
    o = o.transpose(1, 0, 3, 2, 4).reshape(B, S, GLA_HEADS, GLA_HEAD_V)
    o = rms_norm(o, g_norm)
    o = o * jax.nn.silu(g.astype(jnp.float32)).reshape(B, S, GLA_HEADS, GLA_HEAD_V)
    return o.reshape(B, S, GLA_DV).astype(xn.dtype) @ w_o


def sq_relu_mlp(xn, w_up, w_down):
    hid = jnp.square(jax.nn.relu(xn @ w_up))
    return hid @ w_down


def setup_inputs(seed: int = 0) -> dict:
    key = jax.random.key(seed)
    ks = jax.random.split(key, 20)

    def w(k, n, fan_in, fan_out):
        return jax.random.normal(k, (n, fan_in, fan_out), jnp.float32) * (fan_in ** -0.5)

    def gain(k, shape):
        return 1.0 + 0.01 * jax.random.normal(k, shape, jnp.float32)

    x = jax.random.normal(ks[0], (BATCH, SEQ, D_MODEL), jnp.float32)
    positions = jnp.broadcast_to(jnp.arange(SEQ, dtype=jnp.int32), (BATCH, SEQ))
    gla_in_width = 2 * GLA_DK + 2 * GLA_DV + GATE_RANK
    return {
        "x": x,
        "positions": positions,
        "norm_mix": gain(ks[1], (DEPTH, D_MODEL)),
        "norm_mlp": gain(ks[2], (DEPTH, D_MODEL)),
        "mla_w_in": w(ks[3], N_MLA, D_MODEL, Q_LORA + KV_LORA + QK_ROPE),
        "mla_q_norm": gain(ks[4], (N_MLA, Q_LORA)),
        "mla_w_uq": w(ks[5], N_MLA, Q_LORA, MLA_HEADS * (QK_NOPE + QK_ROPE)),
        "mla_kv_norm": gain(ks[6], (N_MLA, KV_LORA)),
        "mla_w_ukv": w(ks[7], N_MLA, KV_LORA, MLA_HEADS * (QK_NOPE + V_HEAD)),
        "mla_w_o": w(ks[8], N_MLA, MLA_HEADS * V_HEAD, D_MODEL),
        "gla_w_in": w(ks[9], N_GLA, D_MODEL, gla_in_width),
        "gla_w_gk_up": w(ks[10], N_GLA, GATE_RANK, GLA_DK),
        "gla_b_gk": 0.1 * jax.random.normal(ks[11], (N_GLA, GLA_DK), jnp.float32),
        "gla_g_norm": gain(ks[12], (N_GLA, GLA_HEAD_V)),
        "gla_w_o": w(ks[13], N_GLA, GLA_DV, D_MODEL),
        "mlp_w_up": w(ks[14], DEPTH, D_MODEL, D_FF),
        "mlp_w_down": w(ks[15], DEPTH, D_FF, D_MODEL),
        "final_norm": gain(ks[16], (D_MODEL,)),
    }


def reference(x, positions, norm_mix, norm_mlp, mla_w_in, mla_q_norm, mla_w_uq, mla_kv_norm,
              mla_w_ukv, mla_w_o, gla_w_in, gla_w_gk_up, gla_b_gk, gla_g_norm, gla_w_o,
              mlp_w_up, mlp_w_down, final_norm):
    for i in range(DEPTH):
        xn = rms_norm(x, norm_mix[i])
        j = i // N_MIXERS
        if i % N_MIXERS == 0:
            mix = mla_mixer(xn, positions, mla_w_in[j], mla_q_norm[j], mla_w_uq[j],
                            mla_kv_norm[j], mla_w_ukv[j], mla_w_o[j])
        else:
            mix = gla_mixer(xn, gla_w_in[j], gla_w_gk_up[j], gla_b_gk[j], gla_g_norm[j], gla_w_o[j])
        x = x + mix.astype(x.dtype)
        x = x + sq_relu_mlp(rms_norm(x, norm_mlp[i]), mlp_w_up[i], mlp_w_down[i]).astype(x.dtype)
    return rms_norm(x, final_norm)
```

```cpp
#include <hip/hip_runtime.h>
#include <hip/hip_cooperative_groups.h>
#include <cstdio>
#include <type_traits>
namespace cg = cooperative_groups;

#define LAS __attribute__((address_space(3)))
typedef unsigned short bf16_t;
typedef short bf16x8 __attribute__((ext_vector_type(8)));
typedef short s16x4 __attribute__((ext_vector_type(4)));
typedef float f32x4 __attribute__((ext_vector_type(4)));
typedef float f32x16 __attribute__((ext_vector_type(16)));
typedef unsigned u32x4 __attribute__((ext_vector_type(4)));
typedef unsigned u32x2 __attribute__((ext_vector_type(2)));

#ifndef N_LAUNCH_MODE
#define N_LAUNCH_MODE 1
#endif

constexpr int S = 16384, D = 1024, DFF = 4096, NTHR = 512;
constexpr float EPS = 1e-6f;
constexpr int LDS_BYTES = 132096 + 1024;

constexpr size_t WS_XB = 0;
constexpr size_t WS_SSQX = WS_XB + (size_t)S * D * 2;
constexpr size_t WS_INVF = WS_SSQX + (size_t)S * 16 * 4;
constexpr size_t WS_BAR = WS_INVF + 1024;
constexpr size_t WS_WMIX = WS_BAR + 16384;
constexpr size_t WMIX_BYTES = (size_t)(3328 + 1024) * 1024 * 2;
constexpr size_t WS_WMLP = WS_WMIX + WMIX_BYTES;
constexpr size_t WS_R = WS_WMLP + (size_t)2 * DFF * D * 2;
constexpr size_t R_HB = WS_R;
constexpr size_t R_SSQKV = R_HB + (size_t)S * 768 * 2;
constexpr size_t R_SSQQ = R_SSQKV + (size_t)S * 16 * 4;
constexpr size_t R_QB = R_SSQQ + (size_t)S * 16 * 4;
constexpr size_t R_KN = R_QB + (size_t)S * 1536 * 2;
constexpr size_t R_VT = R_KN + (size_t)S * 1024 * 2;
constexpr size_t R_OB = R_VT + (size_t)S * 1024 * 2;
constexpr size_t R_MLA_END = R_OB + (size_t)S * 1024 * 2;
constexpr size_t R_HG = WS_R;
constexpr size_t R_AB = R_HG + (size_t)S * 3072 * 2;
constexpr size_t R_U = R_AB + (size_t)S * 16 * 4;
constexpr size_t R_DEC = R_U + (size_t)256 * 4 * 256 * 128 * 2;
constexpr size_t R_Y = R_DEC + (size_t)256 * 4 * 128 * 4;
constexpr size_t R_GLA_END = R_Y + (size_t)S * 1024 * 2;
constexpr size_t R_HID = WS_R;
constexpr size_t R_MLP_END = R_HID + (size_t)S * DFF * 2;
constexpr size_t WS_END = R_GLA_END > R_MLA_END ? (R_GLA_END > R_MLP_END ? R_GLA_END : R_MLP_END) : (R_MLA_END > R_MLP_END ? R_MLA_END : R_MLP_END);
constexpr size_t WM_IN = 0;
constexpr size_t WM_UQ = WM_IN + (size_t)768 * 1024;
constexpr size_t WM_UK = WM_UQ + (size_t)1536 * 384;
constexpr size_t WM_UV = WM_UK + (size_t)1024 * 256;
constexpr size_t WM_O_MLA = WM_UV + (size_t)1024 * 256;
constexpr size_t WM_O_GLA = (size_t)3328 * 1024;

struct Params {
    const float* x; const int* pos; const float* norm_mix; const float* norm_mlp;
    const float* mla_w_in; const float* mla_q_norm; const float* mla_w_uq; const float* mla_kv_norm; const float* mla_w_ukv; const float* mla_w_o;
    const float* gla_w_in; const float* gla_w_gk_up; const float* gla_b_gk; const float* gla_g_norm; const float* gla_w_o;
    const float* mlp_w_up; const float* mlp_w_down; const float* final_norm;
    float* out; unsigned char* ws;
    int ph_lo, ph_hi;
};

typedef const __attribute__((address_space(4))) Params CParams;
__device__ __forceinline__ bf16_t f2bf(float f) { unsigned u = __float_as_uint(f); u += 0x7FFFu + ((u >> 16) & 1u); return (bf16_t)(u >> 16); }
__device__ __forceinline__ float bf2f(bf16_t b) { return __uint_as_float(((unsigned)b) << 16); }
typedef __bf16 bf16v2_t __attribute__((ext_vector_type(2)));
__device__ __forceinline__ unsigned cvt_pk_bf16(float lo, float hi) { bf16v2_t v = {(__bf16)lo, (__bf16)hi}; return __builtin_bit_cast(unsigned, v); }
__device__ __forceinline__ bf16x8 pack8(f32x4 a, f32x4 b) { u32x4 w = {cvt_pk_bf16(a[0], a[1]), cvt_pk_bf16(a[2], a[3]), cvt_pk_bf16(b[0], b[1]), cvt_pk_bf16(b[2], b[3])}; return *reinterpret_cast<bf16x8*>(&w); }
__device__ __forceinline__ f32x16 mfma32(bf16x8 a, bf16x8 b, f32x16 c) { return __builtin_amdgcn_mfma_f32_32x32x16_bf16(a, b, c, 0, 0, 0); }
__device__ __forceinline__ int crow(int r, int hi) { return (r & 3) + 8 * (r >> 2) + 4 * hi; }
__device__ __forceinline__ f32x16 zero16() { f32x16 z; for (int i = 0; i < 16; ++i) z[i] = 0.f; return z; }
__device__ __forceinline__ int opaque_tid(int wv) { int l; asm volatile("v_mbcnt_lo_u32_b32 %0, -1, 0\n\tv_mbcnt_hi_u32_b32 %0, -1, %0" : "=v"(l)); return wv * 64 + l; }
__device__ __forceinline__ float xor16_sum(float x) { auto r = __builtin_amdgcn_permlane16_swap(__float_as_uint(x), __float_as_uint(x), false, false); return __uint_as_float(r[0]) + __uint_as_float(r[1]); }
__device__ __forceinline__ float xor32_sum(float x) { auto r = __builtin_amdgcn_permlane32_swap(__float_as_uint(x), __float_as_uint(x), false, false); return __uint_as_float(r[0]) + __uint_as_float(r[1]); }
__device__ __forceinline__ float xor32_max(float x) { auto r = __builtin_amdgcn_permlane32_swap(__float_as_uint(x), __float_as_uint(x), false, false); return fmaxf(__uint_as_float(r[0]), __uint_as_float(r[1])); }
__device__ __forceinline__ float xor16_max(float x) { auto r = __builtin_amdgcn_permlane16_swap(__float_as_uint(x), __float_as_uint(x), false, false); return fmaxf(__uint_as_float(r[0]), __uint_as_float(r[1])); }
__device__ __forceinline__ f32x4 mfma16(bf16x8 a, bf16x8 b, f32x4 c) { return __builtin_amdgcn_mfma_f32_16x16x32_bf16(a, b, c, 0, 0, 0); }
__device__ __forceinline__ float wave_sum(float x) {
    x = xor32_sum(x); x = xor16_sum(x);
    x += __uint_as_float(__builtin_amdgcn_ds_swizzle(__float_as_uint(x), 0x201F)); x += __uint_as_float(__builtin_amdgcn_ds_swizzle(__float_as_uint(x), 0x101F));
    x += __uint_as_float(__builtin_amdgcn_ds_swizzle(__float_as_uint(x), 0x081F)); x += __uint_as_float(__builtin_amdgcn_ds_swizzle(__float_as_uint(x), 0x041F));
    return x;
}
__device__ __forceinline__ void sincos_acc(float ang, float& sn, float& cs) {
    const double a = (double)ang * 0.63661977236758134308; const double q = __builtin_rint(a);
    const float x = (float)((a - q) * 1.57079632679489661923); const int qi = (int)q; const float x2 = x * x;
    const float s = x + x * x2 * (-1.6666654611e-1f + x2 * (8.3321608736e-3f + x2 * (-1.9515295891e-4f)));
    const float c = 1.0f - 0.5f * x2 + x2 * x2 * (4.166664568298827e-2f + x2 * (-1.388731625493765e-3f + x2 * 2.443315711809948e-5f));
    const int k = qi & 3;
    sn = (k == 0) ? s : (k == 1) ? c : (k == 2) ? -s : -c;
    cs = (k == 0) ? c : (k == 1) ? -s : (k == 2) ? -c : s;
}

namespace pg8 {
constexpr int BM = 256, BK = 64, HALF = 128, HTB = HALF * BK * 2, STAGE_BYTES = 8 * HTB, NXCD = 8, WGM = 8;
__device__ __forceinline__ int lds_byte(int r, int c) { const int st = (r >> 4) * 2 + (c >> 5), rr = r & 15, cc = c & 31, ob = rr * 64 + cc * 2; return st * 1024 + (ob ^ (((ob >> 9) & 1) << 5)); }
__device__ __forceinline__ void stage_rc(int b, int& R, int& C) { const int st = b / 1024, sb = b % 1024, swz = sb ^ (((sb >> 9) & 1) << 5); R = (st >> 1) * 16 + swz / 64; C = (st & 1) * 32 + (swz % 64) / 2; }
__device__ __forceinline__ int perm32(int rho) { const int n = rho >> 4, i = rho & 15; return 8 * (i >> 2) + 4 * n + (i & 3); }
struct Unit { int pm, pn; };
struct Gemm { const bf16_t* A; const bf16_t* Bt; int M, N, K, lda, ldb; };
struct StaticOrder {
    int nM, nN, nwg, G, c;
    __device__ void init(int M, int N, int G_, int c_) { nM = M / BM; nN = N / BM; nwg = nM * nN; G = G_; c = c_; }
    __device__ bool next(int i, Unit& u) const {
        const long L = (long)i * G + c; if (L >= nwg) return false;
        int wgid = (int)L; { const int q = nwg / NXCD, r = nwg % NXCD, xcd = wgid % NXCD, off = wgid / NXCD; wgid = (xcd < r ? xcd * (q + 1) : r * (q + 1) + (xcd - r) * q) + off; }
        const int nig = WGM * nN, gid = wgid / nig, fm = gid * WGM, gsz = (nM - fm) < WGM ? (nM - fm) : WGM;
        u.pm = fm + ((wgid % nig) % gsz); u.pn = (wgid % nig) / gsz; return true;
    }
};

template <class Epi>
__device__ __forceinline__ void gemm_phase(LAS unsigned char* lds, const Gemm g, const StaticOrder& S, const Epi& E, int wv) {
    const int tid = opaque_tid(wv), wid = __builtin_amdgcn_readfirstlane(tid >> 6), lane = tid & 63, wr = wid >> 2, wc = wid & 3, fr = lane & 15, fq = lane >> 4;
    const int K = g.K, nt = K / BK;
    unsigned voffA[2], voffB[2];
#pragma unroll
    for (int i = 0; i < 2; ++i) { int R, C; stage_rc(tid * 16 + i * 8192, R, C); const int Rb = Epi::PERM ? ((R & ~31) + perm32(R & 31)) : R;
        voffA[i] = (unsigned)(R * g.lda + C) * 2u; voffB[i] = (unsigned)(Rb * g.ldb + C) * 2u; }
    const size_t kstep = (size_t)(BK * 2);
    const size_t hstepA = (size_t)HALF * g.lda * 2, hstepB = (size_t)HALF * g.ldb * 2;
    const size_t tstepA = 2 * hstepA, tstepB = 2 * hstepB;
    const unsigned ldsw = (unsigned)wid * 1024u;
    const int aoff = lds_byte(wr * 64 + fr, fq * 8), boff = lds_byte(wc * 32 + fr, fq * 8);
#define PG8_SA(b, h) (((b) * 2 + (h)) * HTB)
#define PG8_SB(b, h) ((4 + (b) * 2 + (h)) * HTB)
#define PG8_STAGE(bufoff, gbase, voff) do { _Pragma("unroll") for (int _i = 0; _i < 2; ++_i) \
        __builtin_amdgcn_global_load_lds((const unsigned*)((const char*)(gbase) + (voff)[_i]), (LAS unsigned*)(lds + (bufoff) + ldsw + _i * 8192), 16, 0, 0); } while (0)
#define PG8_LDA(dst, b, h) do { _Pragma("unroll") for (int m = 0; m < 4; ++m) _Pragma("unroll") for (int k = 0; k < 2; ++k) dst[m][k] = *(const LAS bf16x8*)(lds + PG8_SA(b, h) + aoff + m * 2048 + k * 1024); } while (0)
#define PG8_LDB(dst, b, h) do { _Pragma("unroll") for (int n = 0; n < 2; ++n) _Pragma("unroll") for (int k = 0; k < 2; ++k) dst[n][k] = *(const LAS bf16x8*)(lds + PG8_SB(b, h) + boff + n * 2048 + k * 1024); } while (0)
#define PG8_MMA(ai, bj, At, Bt) do { __builtin_amdgcn_s_setprio(1); _Pragma("unroll") for (int m = 0; m < 4; ++m) _Pragma("unroll") for (int n = 0; n < 2; ++n) _Pragma("unroll") for (int k = 0; k < 2; ++k) \
        acc[ai][bj][m][n] = __builtin_amdgcn_mfma_f32_16x16x32_bf16(Bt[n][k], At[m][k], acc[ai][bj][m][n], 0, 0, 0); __builtin_amdgcn_s_setprio(0); } while (0)
#define PG8_WAIT_V(n) asm volatile("s_waitcnt vmcnt(" #n ")" ::: "memory")
#define PG8_WAIT_L(n) asm volatile("s_waitcnt lgkmcnt(" #n ")" ::: "memory")
#define PG8_BAR __builtin_amdgcn_s_barrier()
#define PG8_SCHED __builtin_amdgcn_sched_barrier(0)
    Unit cur, nxt; int ui = 0;
    if (!S.next(0, cur)) return;
    f32x4 acc[2][2][4][2];
    if constexpr (Epi::INIT) E.init(acc, cur, wr, wc, fr, fq); else {
#pragma unroll
    for (int a = 0; a < 2; ++a)
#pragma unroll
        for (int b = 0; b < 2; ++b)
#pragma unroll
            for (int m = 0; m < 4; ++m)
#pragma unroll
                for (int n = 0; n < 2; ++n) acc[a][b][m][n] = (f32x4){0.f, 0.f, 0.f, 0.f};
    }
    bf16x8 At[4][2], B0[2][2], B1[2][2];
    const char* cA = (const char*)g.A + (size_t)cur.pm * tstepA; const char* cB = (const char*)g.Bt + (size_t)cur.pn * tstepB;
    PG8_STAGE(PG8_SB(0, 0), cB, voffB); PG8_STAGE(PG8_SA(0, 0), cA, voffA); PG8_STAGE(PG8_SB(0, 1), cB + hstepB, voffB); PG8_STAGE(PG8_SA(0, 1), cA + hstepA, voffA);
    if (wr == 1) PG8_BAR;
    PG8_WAIT_V(4); PG8_BAR;
    PG8_STAGE(PG8_SB(1, 0), cB + kstep, voffB); PG8_STAGE(PG8_SA(1, 0), cA + kstep, voffA); PG8_STAGE(PG8_SB(1, 1), cB + hstepB + kstep, voffB);
    PG8_WAIT_V(6); PG8_BAR;
    for (;;) {
        const bool has_next = S.next(ui + 1, nxt);
        const char* nA = has_next ? (const char*)g.A + (size_t)nxt.pm * tstepA : cA; const char* nB = has_next ? (const char*)g.Bt + (size_t)nxt.pn * tstepB : cB;
        for (int t = 0; t < nt; t += 2) {
            const bool last = (t == nt - 2);
            const char* a1 = cA + (size_t)(t + 1) * kstep;
            const char* a2 = last ? nA : cA + (size_t)(t + 2) * kstep; const char* b2 = last ? nB : cB + (size_t)(t + 2) * kstep;
            const char* a3 = a2 + kstep; const char* b3 = b2 + kstep;
            PG8_LDB(B0, 0, 0); PG8_SCHED; PG8_LDA(At, 0, 0); PG8_STAGE(PG8_SA(1, 1), a1 + hstepA, voffA);
            PG8_WAIT_L(8); PG8_BAR; PG8_WAIT_L(0); PG8_MMA(0, 0, At, B0); PG8_BAR; PG8_SCHED;
            PG8_LDB(B1, 0, 1); PG8_STAGE(PG8_SB(0, 0), b2, voffB);
            PG8_BAR; PG8_WAIT_L(0); PG8_MMA(0, 1, At, B1); PG8_BAR;
            PG8_LDA(At, 0, 1); PG8_STAGE(PG8_SA(0, 0), a2, voffA);
            PG8_BAR; PG8_WAIT_L(0); PG8_MMA(1, 0, At, B0); PG8_BAR; PG8_SCHED;
            PG8_STAGE(PG8_SB(0, 1), b2 + hstepB, voffB);
            PG8_WAIT_V(6); PG8_BAR; PG8_MMA(1, 1, At, B1); PG8_BAR;
            PG8_LDB(B0, 1, 0); PG8_SCHED; PG8_LDA(At, 1, 0); PG8_STAGE(PG8_SA(0, 1), a2 + hstepA, voffA);
            PG8_WAIT_L(8); PG8_BAR; PG8_WAIT_L(0); PG8_MMA(0, 0, At, B0); PG8_BAR; PG8_SCHED;
            PG8_LDB(B1, 1, 1); PG8_STAGE(PG8_SB(1, 0), b3, voffB);
            PG8_BAR; PG8_WAIT_L(0); PG8_MMA(0, 1, At, B1); PG8_BAR;
            PG8_LDA(At, 1, 1); PG8_STAGE(PG8_SA(1, 0), a3, voffA);
            PG8_BAR; PG8_WAIT_L(0); PG8_MMA(1, 0, At, B0); PG8_BAR; PG8_SCHED;
            PG8_STAGE(PG8_SB(1, 1), b3 + hstepB, voffB);
            PG8_WAIT_V(6); PG8_BAR; PG8_MMA(1, 1, At, B1); PG8_BAR;
        }
        { int fr2 = fr, fq2 = fq, wr2 = wr, wc2 = wc; asm volatile("" : "+v"(fr2), "+v"(fq2), "+s"(wr2), "+s"(wc2)); E(acc, cur, wr2, wc2, fr2, fq2); }
        if (!has_next) break;
        if constexpr (Epi::INIT) E.init(acc, nxt, wr, wc, fr, fq); else {
#pragma unroll
        for (int a = 0; a < 2; ++a)
#pragma unroll
            for (int b = 0; b < 2; ++b)
#pragma unroll
                for (int m = 0; m < 4; ++m)
#pragma unroll
                    for (int n = 0; n < 2; ++n) acc[a][b][m][n] = (f32x4){0.f, 0.f, 0.f, 0.f};
        }
        cur = nxt; cA = nA; cB = nB; ++ui;
    }
    PG8_WAIT_V(0);
    if (wr == 0) PG8_BAR;
    PG8_BAR;
#undef PG8_SA
#undef PG8_SB
#undef PG8_STAGE
#undef PG8_LDA
#undef PG8_LDB
#undef PG8_MMA
#undef PG8_WAIT_V
#undef PG8_WAIT_L
#undef PG8_BAR
#undef PG8_SCHED
}
}
using pg8::Unit;

__device__ __forceinline__ void row_rstd(float (&rs)[2][4], const float* slots, int nslot4, float invK, int row0, int fq) {
#pragma unroll
    for (int ai = 0; ai < 2; ++ai)
#pragma unroll
        for (int m = 0; m < 4; ++m) {
            const int row = row0 + ai * 128 + m * 16; float s = 0.f;
            if (fq < nslot4) { const f32x4 v = *(const f32x4*)(slots + (size_t)row * 16 + 4 * fq); s = (v[0] + v[1]) + (v[2] + v[3]); }
            s = xor16_sum(s); s = xor32_sum(s);
            rs[ai][m] = rsqrtf(s * invK + EPS);
        }
}
__device__ __forceinline__ float sumsq4(f32x4 v) { return (v[0] * v[0] + v[1] * v[1]) + (v[2] * v[2] + v[3] * v[3]); }
__device__ __forceinline__ void rope8(f32x4& v0, f32x4& v1, int pos, int pair0, const float* invf) {
    const float fp = (float)pos; float sn, cs;
    sincos_acc(fp * invf[pair0 + 0], sn, cs); { const float a = v0[0], b = v0[1]; v0[0] = a * cs - b * sn; v0[1] = b * cs + a * sn; }
    sincos_acc(fp * invf[pair0 + 1], sn, cs); { const float a = v0[2], b = v0[3]; v0[2] = a * cs - b * sn; v0[3] = b * cs + a * sn; }
    sincos_acc(fp * invf[pair0 + 2], sn, cs); { const float a = v1[0], b = v1[1]; v1[0] = a * cs - b * sn; v1[1] = b * cs + a * sn; }
    sincos_acc(fp * invf[pair0 + 3], sn, cs); { const float a = v1[2], b = v1[3]; v1[2] = a * cs - b * sn; v1[3] = b * cs + a * sn; }
}
enum { M_MLAIN = 0, M_Q = 1, M_PLAIN = 2, M_GLAIN = 3, M_SQRELU = 4 };
template <int MODE> struct EpiRow {
    static constexpr bool PERM = true, INIT = false;
    bf16_t* O; int ldc; const float* slots; int nslot4; float invK;
    float* ssq_a; float* ssq_b; float* abuf; const int* pos; const float* invf;
    __device__ __forceinline__ void operator()(const f32x4 (&acc)[2][2][4][2], const Unit& u, int wr, int wc, int fr, int fq) const {
        const int row0 = u.pm * 256 + wr * 64 + fr;
        float rs[2][4]; row_rstd(rs, slots, nslot4, invK, row0, fq);
        const int colw = u.pn * 256 + wc * 32;
#pragma unroll
        for (int ai = 0; ai < 2; ++ai)
#pragma unroll
            for (int m = 0; m < 4; ++m) {
                const int row = row0 + ai * 128 + m * 16; const float r = rs[ai][m];
                float ss0 = 0.f, ss1 = 0.f;
#pragma unroll
                for (int bj = 0; bj < 2; ++bj) {
                    f32x4 v0 = acc[ai][bj][m][0] * r, v1 = acc[ai][bj][m][1] * r;
                    const int col = colw + bj * 128 + 8 * fq;
                    if (MODE == M_MLAIN) {
                        const float q = sumsq4(v0) + sumsq4(v1); if (bj == 0) ss0 = q; else ss1 = q;
                        if (u.pn == 2 && bj == 1 && wc < 2) rope8(v0, v1, pos[row], (wc * 32 + 8 * fq) >> 1, invf);
                    }
                    if (MODE == M_SQRELU) {
#pragma unroll
                        for (int j = 0; j < 4; ++j) { const float a = fmaxf(v0[j], 0.f), b = fmaxf(v1[j], 0.f); v0[j] = a * a; v1[j] = b * b; }
                    }
                    if (MODE == M_GLAIN && u.pn == 12) {
                        if (bj == 0 && wc == 0 && fq < 2) { *(f32x4*)(abuf + (size_t)row * 16 + 8 * fq) = v0; *(f32x4*)(abuf + (size_t)row * 16 + 8 * fq + 4) = v1; }
                    } else {
                        u32x4 w; w.x = cvt_pk_bf16(v0[0], v0[1]); w.y = cvt_pk_bf16(v0[2], v0[3]); w.z = cvt_pk_bf16(v1[0], v1[1]); w.w = cvt_pk_bf16(v1[2], v1[3]);
                        *(u32x4*)(O + (size_t)row * ldc + col) = w;
                    }
                }
                if (MODE == M_MLAIN) {
                    float sa = (u.pn == 2) ? ss0 : ss0 + ss1;
                    sa = xor16_sum(sa); sa = xor32_sum(sa);
                    if (fq == 0) { if (u.pn == 0) ssq_a[(size_t)row * 16 + wc] = sa; else ssq_b[(size_t)row * 16 + (u.pn - 1) * 4 + wc] = sa; }
                }
            }
    }
};
struct EpiVT {
    static constexpr bool PERM = true, INIT = false;
    bf16_t* O; const float* slots; float invK;
    __device__ __forceinline__ void operator()(const f32x4 (&acc)[2][2][4][2], const Unit& u, int wr, int wc, int fr, int fq) const {
        const int row0 = u.pm * 256 + wr * 64 + fr;
#pragma unroll
        for (int bj = 0; bj < 2; ++bj) {
            const int c0 = u.pn * 256 + bj * 128 + wc * 32 + 8 * fq; float rt[8];
#pragma unroll
            for (int t = 0; t < 8; ++t) { const f32x4 v = *(const f32x4*)(slots + (size_t)(c0 + t) * 16); rt[t] = rsqrtf(((v[0] + v[1]) + (v[2] + v[3])) * invK + EPS); }
#pragma unroll
            for (int ai = 0; ai < 2; ++ai)
#pragma unroll
                for (int m = 0; m < 4; ++m) {
                    const int row = row0 + ai * 128 + m * 16; const f32x4 v0 = acc[ai][bj][m][0], v1 = acc[ai][bj][m][1];
                    u32x4 w; w.x = cvt_pk_bf16(v0[0] * rt[0], v0[1] * rt[1]); w.y = cvt_pk_bf16(v0[2] * rt[2], v0[3] * rt[3]); w.z = cvt_pk_bf16(v1[0] * rt[4], v1[1] * rt[5]); w.w = cvt_pk_bf16(v1[2] * rt[6], v1[3] * rt[7]);
                    const int t0 = c0 & 31, pb = t0 >> 4, pw = (t0 >> 2) & 3; bf16_t* dst = O + (size_t)row * S + (c0 & ~31) + 4 * pb;
                    *(u32x2*)(dst + 8 * pw) = (u32x2){w.x, w.y}; *(u32x2*)(dst + 8 * (pw + 1)) = (u32x2){w.z, w.w};
                }
        }
    }
};
struct EpiRes {
    static constexpr bool PERM = true, INIT = true;
    bf16_t* xb; float* ssq;
    __device__ __forceinline__ void init(f32x4 (&acc)[2][2][4][2], const Unit& u, int wr, int wc, int fr, int fq) const {
        const int row0 = u.pm * 256 + wr * 64 + fr, col0 = u.pn * 256 + wc * 32 + 8 * fq;
#pragma unroll
        for (int ai = 0; ai < 2; ++ai)
#pragma unroll
            for (int m = 0; m < 4; ++m)
#pragma unroll
                for (int bj = 0; bj < 2; ++bj) {
                    const bf16x8 old = *(const bf16x8*)(xb + (size_t)(row0 + ai * 128 + m * 16) * D + col0 + bj * 128);
#pragma unroll
                    for (int i = 0; i < 4; ++i) { acc[ai][bj][m][0][i] = bf2f((bf16_t)old[i]); acc[ai][bj][m][1][i] = bf2f((bf16_t)old[4 + i]); }
                }
    }
    __device__ __forceinline__ void operator()(const f32x4 (&acc)[2][2][4][2], const Unit& u, int wr, int wc, int fr, int fq) const {
        const int row0 = u.pm * 256 + wr * 64 + fr, col0 = u.pn * 256 + wc * 32 + 8 * fq;
#pragma unroll
        for (int ai = 0; ai < 2; ++ai)
#pragma unroll
            for (int m = 0; m < 4; ++m) {
                const int row = row0 + ai * 128 + m * 16; float ss = 0.f;
#pragma unroll
                for (int bj = 0; bj < 2; ++bj) {
                    const f32x4 o0 = acc[ai][bj][m][0], o1 = acc[ai][bj][m][1];
                    ss += sumsq4(o0) + sumsq4(o1);
                    *(bf16x8*)(xb + (size_t)row * D + col0 + bj * 128) = pack8(o0, o1);
                }
                ss = xor16_sum(ss); ss = xor32_sum(ss);
                if (fq == 0) ssq[(size_t)row * 16 + u.pn * 4 + wc] = ss;
            }
    }
};
template <class Epi> __device__ __forceinline__ void run_gemm(LAS unsigned char* lds, const bf16_t* A, int lda, const bf16_t* Bt, int ldb, int M, int N, int K, const Epi& E, int rot, int wv) {
    pg8::Gemm g{A, Bt, M, N, K, lda, ldb}; pg8::StaticOrder So; So.init(M, N, (int)gridDim.x, (int)((blockIdx.x + rot) % gridDim.x));
    pg8::gemm_phase<Epi>(lds, g, So, E, wv);
}

enum { CM_PLAIN = 0, CM_MLAIN = 1, CM_UQ = 2, CM_UK = 3, CM_UV = 4 };
__device__ __forceinline__ int colmap(int kind, int n, int Nsrc) {
    switch (kind) {
        case CM_MLAIN: { if (n < 256) return 384 + n; if (n < 640) return n - 256; if (n < 704) { const int j = n - 640; return 640 + (j >> 1) + 32 * (j & 1); } return -1; }
        case CM_UQ: { const int h = n / 192, r = n % 192; if (r < 128) return h * 192 + r; const int j = r - 128; return h * 192 + 128 + (j >> 1) + 32 * (j & 1); }
        case CM_UK: return (n >> 7) * 256 + (n & 127);
        case CM_UV: return (n >> 7) * 256 + 128 + (n & 127);
        default: return n < Nsrc ? n : -1;
    }
}
__device__ __forceinline__ void conv_w(LAS unsigned char* lds, int kind, const float* src, int K, int Nsrc, bf16_t* dst, int Ndst, const float* gain, float fac, int rot, int wv, int wgi, int nwgi) {
    LAS float* tile = (LAS float*)lds;
    const int tid = opaque_tid(wv), ntk = K / 64, ntn = Ndst / 64, nwg = nwgi, wg = (wgi + rot) % nwg;
    for (int t = wg; t < ntk * ntn; t += nwg) {
        const int kt = t % ntk, nt_ = t / ntk;
        const int nn = tid & 63, sc = colmap(kind, nt_ * 64 + nn, Nsrc);
#pragma unroll
        for (int j = 0; j < 8; ++j) { const int kk = (tid >> 6) + 8 * j, k = kt * 64 + kk; float v = 0.f; if (sc >= 0) { v = src[(size_t)k * Nsrc + sc] * fac; if (gain) v *= gain[k]; } tile[kk * 65 + nn] = v; }
        __syncthreads();
        { const int n = tid >> 3, k8 = (tid & 7) * 8; f32x4 a, b;
#pragma unroll
          for (int j = 0; j < 4; ++j) { a[j] = tile[(k8 + j) * 65 + n]; b[j] = tile[(k8 + 4 + j) * 65 + n]; }
          *(bf16x8*)(dst + (size_t)(nt_ * 64 + n) * K + kt * 64 + k8) = pack8(a, b); }
        __syncthreads();
    }
}
__device__ __forceinline__ void conv_plain(const float* src, int K, int Nsrc, bf16_t* dst, int Ndst, const float* gain, int rot, int wv, int wgi, int nwgi) {
    const int tid = opaque_tid(wv), lane = tid & 63, k8 = lane & 7, n4 = lane >> 3;
    const int ntk = K / 64, ntn = Ndst / 32, nw = nwgi * 8, w = ((wgi + rot) % nwgi) * 8 + (tid >> 6);
    for (int t = w; t < ntk * ntn; t += nw) {
        const int kt = t % ntk, nt_ = t / ntk, n = nt_ * 32 + 4 * n4, k = kt * 64 + 8 * k8;
        f32x4 v[8];
        if (n < Nsrc) {
#pragma unroll
            for (int i = 0; i < 8; ++i) v[i] = __builtin_nontemporal_load((const f32x4*)(src + (size_t)(k + i) * Nsrc + n));
            if (gain) {
                const f32x4 g0 = *(const f32x4*)(gain + k), g1 = *(const f32x4*)(gain + k + 4);
#pragma unroll
                for (int i = 0; i < 4; ++i) { v[i] *= g0[i]; v[4 + i] *= g1[i]; }
            }
        } else {
#pragma unroll
            for (int i = 0; i < 8; ++i) v[i] = (f32x4){0.f, 0.f, 0.f, 0.f};
        }
#pragma unroll
        for (int j = 0; j < 4; ++j)
            *(bf16x8*)(dst + (size_t)(n + j) * K + k) = pack8((f32x4){v[0][j], v[1][j], v[2][j], v[3][j]}, (f32x4){v[4][j], v[5][j], v[6][j], v[7][j]});
    }
}
struct ConvJob { int kind; const float* src; int K, Nsrc; bf16_t* dst; int Ndst; const float* gain; float fac; int rot; };
__device__ __forceinline__ bool get_job(CParams& p, int layer, int which, int ji, ConvJob& J) {
    bf16_t* wm = (bf16_t*)(p.ws + WS_WMIX); bf16_t* wl = (bf16_t*)(p.ws + WS_WMLP); const int j = layer >> 1;
    if (which == 1) {
        if (ji == 0) { J = ConvJob{CM_PLAIN, p.mlp_w_up + (size_t)layer * D * DFF, D, DFF, wl, DFF, p.norm_mlp + layer * D, 1.f, 0}; return true; }
        if (ji == 1) { J = ConvJob{CM_PLAIN, p.mlp_w_down + (size_t)layer * D * DFF, DFF, D, wl + (size_t)DFF * D, D, nullptr, 1.f, 0}; return true; }
        return false;
    }
    const float* gmix = p.norm_mix + layer * D;
    if ((layer & 1) == 0) {
        switch (ji) {
            case 0: J = ConvJob{CM_MLAIN, p.mla_w_in + (size_t)j * 1024 * 704, 1024, 704, wm + WM_IN, 768, gmix, 1.f, 0}; return true;
            case 1: J = ConvJob{CM_UQ, p.mla_w_uq + (size_t)j * 384 * 1536, 384, 1536, wm + WM_UQ, 1536, p.mla_q_norm + j * 384, 0.07216878364870323f * 1.4426950408889634f, 192}; return true;
            case 2: J = ConvJob{CM_UK, p.mla_w_ukv + (size_t)j * 256 * 2048, 256, 2048, wm + WM_UK, 1024, p.mla_kv_norm + j * 256, 1.f, 80}; return true;
            case 3: J = ConvJob{CM_UV, p.mla_w_ukv + (size_t)j * 256 * 2048, 256, 2048, wm + WM_UV, 1024, p.mla_kv_norm + j * 256, 1.f, 144}; return true;
            case 4: J = ConvJob{CM_PLAIN, p.mla_w_o + (size_t)j * 1024 * 1024, 1024, 1024, wm + WM_O_MLA, 1024, nullptr, 1.f, 208}; return true;
            default: return false;
        }
    } else {
        if (ji == 0) { J = ConvJob{CM_PLAIN, p.gla_w_in + (size_t)j * 1024 * 3088, 1024, 3088, wm + WM_IN, 3328, gmix, 1.f, 0}; return true; }
        if (ji == 1) { J = ConvJob{CM_PLAIN, p.gla_w_o + (size_t)j * 1024 * 1024, 1024, 1024, wm + WM_O_GLA, 1024, nullptr, 1.f, 64}; return true; }
        return false;
    }
}
__device__ __forceinline__ void conv_run(CParams& p, LAS unsigned char* lds, int layer, int which, int wv, int wgi, int nwgi) {
    for (int ji = 0; ji < 5; ++ji) { ConvJob J; if (!get_job(p, layer, which, ji, J)) break; if (J.kind == CM_PLAIN) conv_plain(J.src, J.K, J.Nsrc, J.dst, J.Ndst, J.gain, J.rot, wv, wgi, nwgi); else conv_w(lds, J.kind, J.src, J.K, J.Nsrc, J.dst, J.Ndst, J.gain, J.fac, J.rot, wv, wgi, nwgi); }
}
__device__ __forceinline__ void conv_mixer(CParams& p, LAS unsigned char* lds, int layer, int wv) { conv_run(p, lds, layer, 0, wv, (int)blockIdx.x, (int)gridDim.x); }
__device__ __forceinline__ void conv_mlp(CParams& p, LAS unsigned char* lds, int layer, int wv) { conv_run(p, lds, layer, 1, wv, (int)blockIdx.x, (int)gridDim.x); }
__device__ __forceinline__ void conv_mlp_weighted(CParams& p, LAS unsigned char* lds, int layer, int wv, int nbusy) {
    const int G = (int)gridDim.x, b = (int)blockIdx.x;
    if (nbusy >= G) { conv_run(p, lds, layer, 1, wv, b, G); return; }
    const int nv = nbusy + 3 * (G - nbusy);
    if (b < nbusy) conv_run(p, lds, layer, 1, wv, b, nv);
    else for (int t = 0; t < 3; ++t) conv_run(p, lds, layer, 1, wv, nbusy + 3 * (b - nbusy) + t, nv);
}

__device__ __forceinline__ void prologue_x(CParams& p, int wv) {
    const int tid = opaque_tid(wv), lane = tid & 63, gw = blockIdx.x * 8 + (tid >> 6), nw = gridDim.x * 8;
    bf16_t* xb = (bf16_t*)(p.ws + WS_XB); float* ssq = (float*)(p.ws + WS_SSQX);
    for (int row = gw; row < S; row += nw) {
        const float* xr = p.x + (size_t)row * D; float ss = 0.f;
#pragma unroll
        for (int i = 0; i < 4; ++i) { const f32x4 v = *(const f32x4*)(xr + i * 256 + lane * 4); ss += sumsq4(v); u32x2 w; w.x = cvt_pk_bf16(v[0], v[1]); w.y = cvt_pk_bf16(v[2], v[3]); *(u32x2*)(xb + (size_t)row * D + i * 256 + lane * 4) = w; }
        ss = wave_sum(ss);
        if (lane < 16) ssq[(size_t)row * 16 + lane] = (lane == 0) ? ss : 0.f;
    }
    if (blockIdx.x == 0 && tid < 32) { float* f = (float*)(p.ws + WS_INVF); f[tid] = 1.0f / powf(10000.0f, (float)(2 * tid) * (1.0f / 64.0f)); }
}
__device__ __forceinline__ void final_norm(CParams& p, int wv) {
    const int tid = opaque_tid(wv), lane = tid & 63, gw = blockIdx.x * 8 + (tid >> 6), nw = gridDim.x * 8;
    const bf16_t* xbp = (const bf16_t*)(p.ws + WS_XB);
    for (int row = gw; row < S; row += nw) {
        const bf16_t* xr = xbp + (size_t)row * D; float* orow = p.out + (size_t)row * D; f32x4 v[4]; float ss = 0.f;
#pragma unroll
        for (int i = 0; i < 2; ++i) { const bf16x8 t = *(const bf16x8*)(xr + i * 512 + lane * 8);
#pragma unroll
            for (int q = 0; q < 4; ++q) { v[2 * i][q] = bf2f((bf16_t)t[q]); v[2 * i + 1][q] = bf2f((bf16_t)t[4 + q]); }
            ss += sumsq4(v[2 * i]) + sumsq4(v[2 * i + 1]); }
        ss = wave_sum(ss);
        const float r = rsqrtf(ss * (1.0f / D) + EPS);
#pragma unroll
        for (int i = 0; i < 2; ++i) { const f32x4 g0 = *(const f32x4*)(p.final_norm + i * 512 + lane * 8), g1 = *(const f32x4*)(p.final_norm + i * 512 + lane * 8 + 4);
            *(f32x4*)(orow + i * 512 + lane * 8) = v[2 * i] * r * g0; *(f32x4*)(orow + i * 512 + lane * 8 + 4) = v[2 * i + 1] * r * g1; }
    }
}

constexpr int KROW = 400, VROW = 144, KTILE_B = 64 * KROW, VTILE_B = 128 * VROW, ATT_BUF = KTILE_B + VTILE_B;
__device__ __forceinline__ void attn_phase(CParams& p, LAS unsigned char* lds, int wv) {
    const int tid = opaque_tid(wv), wid = __builtin_amdgcn_readfirstlane(tid >> 6), lane_w = tid & 63;
    const bf16_t* qbp = (const bf16_t*)(p.ws + R_QB); bf16_t* ob = (bf16_t*)(p.ws + R_OB);
    for (int item = blockIdx.x; item < 256; item += gridDim.x) {
        const int h = item & 7, pr = item >> 3;
        for (int half = 0; half < 2; ++half) {
            int lane_o = lane_w; asm volatile("" : "+v"(lane_o));
            const int lane = lane_o, j16 = lane & 15, quad = lane >> 4, gsw = ((j16 >> 2) ^ (j16 >> 3)) & 1, kgx = quad ^ gsw;
            const int qblk = half == 0 ? 63 - pr : pr, ntile = 4 * qblk + 4;
            const int q0 = qblk * 256 + wid * 32, last_tile = (q0 + 31) >> 6;
            unsigned goff[6], gstr[6];
#pragma unroll
            for (int j = 0; j < 6; ++j) {
                const int g = (wid + 8 * j) * 64 + lane;
                if (g < 1600) { const int row = g / 25, sc = g % 25, cc = sc < 24 ? (sc ^ (((row >> 2) ^ (row >> 3)) & 1)) : 0;
                    if (cc >= 16) { goff[j] = (unsigned)R_HB + (unsigned)(row * 768 + 640 + (cc - 16) * 8) * 2u; gstr[j] = 64u * 768u * 2u; }
                    else { goff[j] = (unsigned)R_KN + (unsigned)(row * 1024 + h * 128 + cc * 8) * 2u; gstr[j] = 64u * 1024u * 2u; } }
                else { const int g2 = g - 1600, d = g2 / 9, sc = g2 % 9, cc = sc < 8 ? (sc ^ (((d >> 2) ^ (d >> 3)) & 1)) : 0;
                    goff[j] = (unsigned)R_VT + (unsigned)((h * 128 + d) * S + cc * 8) * 2u; gstr[j] = 128u; }
            }
            __builtin_amdgcn_sched_barrier(0);
            bf16x8 qf[2][6];
#pragma unroll
            for (int qb = 0; qb < 2; ++qb)
#pragma unroll
                for (int s = 0; s < 6; ++s) qf[qb][s] = *(const bf16x8*)(qbp + (size_t)(q0 + 16 * qb + j16) * 1536 + h * 192 + 32 * s + 8 * quad);
            { const float* invf = (const float*)(p.ws + WS_INVF);
#pragma unroll
              for (int qb = 0; qb < 2; ++qb) { const int qpos = p.pos[q0 + 16 * qb + j16];
#pragma unroll
                for (int s = 4; s < 6; ++s) {
                  f32x4 v0, v1; for (int i = 0; i < 4; ++i) { v0[i] = bf2f((bf16_t)qf[qb][s][i]); v1[i] = bf2f((bf16_t)qf[qb][s][4 + i]); }
                  rope8(v0, v1, qpos, 16 * (s - 4) + 4 * quad, invf); qf[qb][s] = pack8(v0, v1); __builtin_amdgcn_sched_barrier(0); } } }
            f32x4 o[8][2];
#pragma unroll
            for (int db = 0; db < 8; ++db) { o[db][0] = (f32x4){0.f, 0.f, 0.f, 0.f}; o[db][1] = (f32x4){0.f, 0.f, 0.f, 0.f}; }
            float mrun[2] = {0.f, 0.f}, lrun[2] = {0.f, 0.f};
            f32x4 negm[2] = {(f32x4){0.f, 0.f, 0.f, 0.f}, (f32x4){0.f, 0.f, 0.f, 0.f}};
            const int nld = wid < 3 ? 6 : 5;
#define ATT_ISSUE(slot_) do { _Pragma("unroll") for (int j = 0; j < 6; ++j) if (j < nld) { \
                __builtin_amdgcn_global_load_lds((const unsigned*)(p.ws + goff[j]), (LAS unsigned*)(lds + (slot_) * ATT_BUF + (wid + 8 * j) * 1024), 16, 0, 0); goff[j] += gstr[j]; } } while (0)
            ATT_ISSUE(0);
            if (ntile > 1) ATT_ISSUE(1);
            int slot = 0;
            for (int kt = 0; kt < ntile; ++kt) {
                const int cur = slot * ATT_BUF;
                if (kt + 1 < ntile) { if (wid < 3) asm volatile("s_waitcnt vmcnt(6)" ::: "memory"); else asm volatile("s_waitcnt vmcnt(5)" ::: "memory"); }
                else asm volatile("s_waitcnt vmcnt(0)" ::: "memory");
                __builtin_amdgcn_s_barrier();
                asm volatile("" ::: "memory");
                if (kt + 2 < ntile) { const int s2 = slot == 0 ? 2 : slot - 1; ATT_ISSUE(s2); }
                if (kt <= last_tile) {
                    f32x4 sa[4][2];
                    const LAS unsigned char* kbase = lds + cur + j16 * KROW + 16 * kgx;
#pragma unroll
                    for (int s = 0; s < 6; ++s)
#pragma unroll
                        for (int kb = 0; kb < 4; ++kb) {
                            const bf16x8 kf = *(const LAS bf16x8*)(kbase + kb * 16 * KROW + 64 * s);
                            sa[kb][0] = mfma16(kf, qf[0][s], s == 0 ? negm[0] : sa[kb][0]); sa[kb][1] = mfma16(kf, qf[1][s], s == 0 ? negm[1] : sa[kb][1]);
                        }
                    if (kt * 64 + 63 > q0) {
                        const float NEG = -__builtin_inff();
#pragma unroll
                        for (int qb = 0; qb < 2; ++qb) { const int dq = q0 + 16 * qb + j16 - kt * 64 - 4 * quad;
#pragma unroll
                            for (int kb = 0; kb < 4; ++kb)
#pragma unroll
                                for (int r = 0; r < 4; ++r) if (16 * kb + r > dq) sa[kb][qb][r] = NEG; }
                    }
                    float tmax[2];
#pragma unroll
                    for (int qb = 0; qb < 2; ++qb) { float m = sa[0][qb][0];
#pragma unroll
                        for (int kb = 0; kb < 4; ++kb)
#pragma unroll
                            for (int r = 0; r < 4; ++r) m = fmaxf(m, sa[kb][qb][r]);
                        tmax[qb] = xor16_max(xor32_max(m)); }
                    if (kt == 0 || __builtin_amdgcn_ballot_w64(tmax[0] > 8.0f || tmax[1] > 8.0f) != 0ull) {
#pragma unroll
                        for (int qb = 0; qb < 2; ++qb) { const float d = kt == 0 ? tmax[qb] : fmaxf(tmax[qb], 0.f), alpha = kt == 0 ? 1.0f : __builtin_amdgcn_exp2f(-d); mrun[qb] += d; lrun[qb] *= alpha;
                            negm[qb] = (f32x4){-mrun[qb], -mrun[qb], -mrun[qb], -mrun[qb]};
#pragma unroll
                            for (int kb = 0; kb < 4; ++kb) sa[kb][qb] -= d;
#pragma unroll
                            for (int db = 0; db < 8; ++db) o[db][qb] *= alpha; }
                    }
#pragma unroll
                    for (int qb = 0; qb < 2; ++qb) { float ps = 0.f;
#pragma unroll
                        for (int kb = 0; kb < 4; ++kb)
#pragma unroll
                            for (int r = 0; r < 4; ++r) { const float e = __builtin_amdgcn_exp2f(sa[kb][qb][r]); sa[kb][qb][r] = e; ps += e; }
                        lrun[qb] += ps; }
                    bf16x8 pfr[2][2];
#pragma unroll
                    for (int qb = 0; qb < 2; ++qb) { pfr[qb][0] = pack8(sa[0][qb], sa[1][qb]); pfr[qb][1] = pack8(sa[2][qb], sa[3][qb]); }
                    const LAS unsigned char* vbase = lds + cur + KTILE_B + j16 * VROW + 16 * kgx;
#pragma unroll
                    for (int ks = 0; ks < 2; ++ks)
#pragma unroll
                        for (int db = 0; db < 8; ++db) {
                            const bf16x8 vf = *(const LAS bf16x8*)(vbase + db * 16 * VROW + 64 * ks);
                            o[db][0] = mfma16(vf, pfr[0][ks], o[db][0]); o[db][1] = mfma16(vf, pfr[1][ks], o[db][1]);
                        }
                }
                slot = slot == 2 ? 0 : slot + 1;
            }
#undef ATT_ISSUE
            asm volatile("s_waitcnt lgkmcnt(0)" ::: "memory");
            __builtin_amdgcn_s_barrier();
            asm volatile("" ::: "memory");
#pragma unroll
            for (int qb = 0; qb < 2; ++qb) {
                const float l = xor16_sum(xor32_sum(lrun[qb])), inv = 1.0f / l;
                bf16_t* orow = ob + (size_t)(q0 + 16 * qb + j16) * 1024 + h * 128 + 4 * quad;
#pragma unroll
                for (int db = 0; db < 8; ++db) { u32x2 w; w.x = cvt_pk_bf16(o[db][qb][0] * inv, o[db][qb][1] * inv); w.y = cvt_pk_bf16(o[db][qb][2] * inv, o[db][qb][3] * inv); *(u32x2*)(orow + 16 * db) = w; }
            }
        }
    }
}

constexpr int TROW = 72;
__device__ __forceinline__ void stage_vT(LAS bf16_t* vTl, const bf16_t* hg, int c, int h, int wv) {
    const int tid = opaque_tid(wv);
#pragma unroll
    for (int j = 0; j < 4; ++j) { const int ch = tid + 512 * j, t = ch >> 5, e8 = (ch & 31) * 8;
        const bf16x8 v = *(const bf16x8*)(hg + (size_t)(64 * c + t) * 3072 + 1024 + 256 * h + e8);
#pragma unroll
        for (int i = 0; i < 8; ++i) vTl[(e8 + i) * TROW + (t ^ (((e8 >> 3) & 7) << 3))] = (bf16_t)v[i]; }
}
__device__ __forceinline__ void gla_gate_proj(CParams& p, LAS unsigned char* lds, int wv) {
    const int tid = opaque_tid(wv), wid = __builtin_amdgcn_readfirstlane(tid >> 6), lane = tid & 63, c = lane & 31, hi = lane >> 5;
    const bf16_t* xbp = (const bf16_t*)(p.ws + WS_XB); const bf16_t* wa = (const bf16_t*)(p.ws + WS_WMIX) + (size_t)3072 * 1024;
    const float* ssq = (const float*)(p.ws + WS_SSQX); float* ab = (float*)(p.ws + R_AB);
    LAS float* part = (LAS float*)lds;
    for (int blk = blockIdx.x; blk < S / 64; blk += gridDim.x) {
        const int r0 = blk * 64;
        f32x16 acc0 = zero16(), acc1 = zero16();
#pragma unroll
        for (int s = 0; s < 8; ++s) {
            const int ko = 16 * (wid * 8 + s) + 8 * hi;
            const bf16x8 b = *(const bf16x8*)(wa + (size_t)(c & 15) * 1024 + ko);
            const bf16x8 a0 = *(const bf16x8*)(xbp + (size_t)(r0 + c) * 1024 + ko), a1 = *(const bf16x8*)(xbp + (size_t)(r0 + 32 + c) * 1024 + ko);
            acc0 = mfma32(a0, b, acc0); acc1 = mfma32(a1, b, acc1);
        }
        if (c < 16) {
#pragma unroll
            for (int r = 0; r < 16; ++r) { part[(wid * 64 + crow(r, hi)) * 16 + c] = acc0[r]; part[(wid * 64 + 32 + crow(r, hi)) * 16 + c] = acc1[r]; }
        }
        __syncthreads();
#pragma unroll
        for (int jj = 0; jj < 2; ++jj) {
            const int idx = tid + 512 * jj, row = idx >> 4, col = idx & 15; float s = 0.f;
#pragma unroll
            for (int w8 = 0; w8 < 8; ++w8) s += part[(w8 * 64 + row) * 16 + col];
            float q = 0.f;
#pragma unroll
            for (int i = 0; i < 4; ++i) { const f32x4 v = *(const f32x4*)(ssq + (size_t)(r0 + row) * 16 + 4 * i); q += (v[0] + v[1]) + (v[2] + v[3]); }
            ab[(size_t)(r0 + row) * 16 + col] = s * rsqrtf(q * (1.0f / 1024.0f) + EPS);
        }
        __syncthreads();
    }
}
__device__ __forceinline__ void gla_passA(CParams& p, LAS unsigned char* lds, int j, int wv) {
    const int tid = opaque_tid(wv), wid = __builtin_amdgcn_readfirstlane(tid >> 6), lane = tid & 63, c = lane & 31, hi = lane >> 5;
    LAS bf16_t* kTl = (LAS bf16_t*)lds; LAS bf16_t* vTl = (LAS bf16_t*)(lds + 128 * TROW * 2); LAS float* tot = (LAS float*)(lds + (128 + 256) * TROW * 2);
    bf16_t* hg = (bf16_t*)(p.ws + R_HG); const float* ab = (const float*)(p.ws + R_AB); bf16_t* U = (bf16_t*)(p.ws + R_U); float* dec = (float*)(p.ws + R_DEC);
    const float* Wg = p.gla_w_gk_up + (size_t)j * 16 * 512; const float* bg = p.gla_b_gk + j * 512;
    for (int item = blockIdx.x; item < 1024; item += gridDim.x) {
        const int ch = item >> 2, h = item & 3, d = tid & 127, tg = tid >> 7;
        float w[16];
#pragma unroll
        for (int r = 0; r < 16; ++r) w[r] = Wg[r * 512 + 128 * h + d];
        const float bias = bg[128 * h + d];
        float cum[16]; float run = 0.f;
        const size_t ro0 = (size_t)(64 * ch + 16 * tg) * 3072 + 128 * h + d;
        bf16_t qraw[16], kraw[16];
#pragma unroll
        for (int tt = 0; tt < 16; ++tt) { qraw[tt] = hg[ro0 + (size_t)tt * 3072]; kraw[tt] = hg[ro0 + (size_t)tt * 3072 + 512]; }
#pragma unroll
        for (int tt = 0; tt < 16; ++tt) {
            const float* ar = ab + (size_t)(64 * ch + 16 * tg + tt) * 16; float z = bias;
#pragma unroll
            for (int r4 = 0; r4 < 4; ++r4) { const f32x4 a = *(const f32x4*)(ar + 4 * r4); z += a[0] * w[4 * r4] + a[1] * w[4 * r4 + 1] + a[2] * w[4 * r4 + 2] + a[3] * w[4 * r4 + 3]; }
            const float ls = fminf(z, 0.f) - __logf(1.0f + __expf(-fabsf(z)));
            run += ls * 0.0625f; cum[tt] = run;
        }
        tot[tg * 128 + d] = run;
        __syncthreads();
        float off = 0.f, total = 0.f;
#pragma unroll
        for (int g = 0; g < 4; ++g) { const float t_ = tot[g * 128 + d]; total += t_; if (g < tg) off += t_; }
#pragma unroll
        for (int tt = 0; tt < 16; ++tt) {
            const float b = cum[tt] + off; const size_t ro = ro0 + (size_t)tt * 3072;
            const float qv = bf2f(qraw[tt]), kv = bf2f(kraw[tt]);
            const float eb = __expf(b), enb = __expf(-b);
            hg[ro] = f2bf(qv * 0.08838834764831845f * eb);
            hg[ro + 512] = f2bf(kv * enb);
            kTl[d * TROW + 16 * tg + tt] = f2bf(kv * __expf(total - b));
        }
        if (tg == 0) dec[(size_t)item * 128 + d] = __expf(total);
        stage_vT(vTl, hg, ch, h, wv);
        __syncthreads();
        f32x16 acc[4]; for (int i = 0; i < 4; ++i) acc[i] = zero16();
#pragma unroll
        for (int s = 0; s < 4; ++s) {
            const bf16x8 bf = *(const LAS bf16x8*)(vTl + (32 * wid + c) * TROW + (((2 * s + hi) ^ (((32 * wid + c) >> 3) & 7)) << 3));
#pragma unroll
            for (int db = 0; db < 4; ++db) { const bf16x8 af = *(const LAS bf16x8*)(kTl + (32 * db + c) * TROW + 16 * s + 8 * hi); acc[db] = mfma32(af, bf, acc[db]); }
        }
        bf16_t* up = U + ((size_t)item * 256 + 32 * wid + c) * 128;
#pragma unroll
        for (int db = 0; db < 4; ++db)
#pragma unroll
            for (int g = 0; g < 4; ++g) { u32x2 wv; wv.x = cvt_pk_bf16(acc[db][4 * g], acc[db][4 * g + 1]); wv.y = cvt_pk_bf16(acc[db][4 * g + 2], acc[db][4 * g + 3]); *(u32x2*)(up + 32 * db + 8 * g + 4 * hi) = wv; }
        __syncthreads();
    }
}
__device__ __forceinline__ void gla_scan(CParams& p, int wv) {
    bf16_t* U = (bf16_t*)(p.ws + R_U); const float* dec = (const float*)(p.ws + R_DEC);
    const int tid = opaque_tid(wv);
    for (int idx = blockIdx.x * NTHR + tid; idx < 4 * 256 * 128; idx += gridDim.x * NTHR) {
        const int h = idx >> 15, rem = idx & 32767, d = rem & 127;
        bf16_t* up = U + (size_t)h * 32768 + rem; const float* dp = dec + h * 128 + d; float st = 0.f;
        for (int c0 = 0; c0 < 256; c0 += 32) {
            float u[32], dc[32];
#pragma unroll
            for (int i = 0; i < 32; ++i) { u[i] = bf2f(up[(size_t)(c0 + i) * 131072]); dc[i] = dp[(size_t)(c0 + i) * 512]; }
#pragma unroll
            for (int i = 0; i < 32; ++i) { up[(size_t)(c0 + i) * 131072] = f2bf(st); st = st * dc[i] + u[i]; }
        }
    }
}
__device__ __forceinline__ void gla_passC(CParams& p, LAS unsigned char* lds, int j, int wv) {
    const int tid = opaque_tid(wv), wid = __builtin_amdgcn_readfirstlane(tid >> 6), lane = tid & 63, c = lane & 31, hi = lane >> 5;
    LAS bf16_t* vTl = (LAS bf16_t*)lds; LAS bf16_t* at = (LAS bf16_t*)(lds + 256 * TROW * 2); LAS float* red = (LAS float*)(lds + (256 + 64) * TROW * 2);
    const bf16_t* hg = (const bf16_t*)(p.ws + R_HG); const bf16_t* Sb = (const bf16_t*)(p.ws + R_U); bf16_t* y = (bf16_t*)(p.ws + R_Y);
    const float* gn = p.gla_g_norm + j * 256;
    for (int item = blockIdx.x; item < 1024; item += gridDim.x) {
        const int ch = item >> 2, h = item & 3;
        stage_vT(vTl, hg, ch, h, wv);
        if (wid < 3) {
            const int tb = wid == 0 ? 0 : 1, sb = wid == 2 ? 1 : 0; f32x16 a = zero16();
#pragma unroll
            for (int s = 0; s < 8; ++s) {
                const bf16x8 qf = *(const bf16x8*)(hg + (size_t)(64 * ch + 32 * tb + c) * 3072 + 128 * h + 16 * s + 8 * hi);
                const bf16x8 kf = *(const bf16x8*)(hg + (size_t)(64 * ch + 32 * sb + c) * 3072 + 512 + 128 * h + 16 * s + 8 * hi);
                a = mfma32(qf, kf, a);
            }
#pragma unroll
            for (int r = 0; r < 16; ++r) { const int t = crow(r, hi); float v = a[r]; if (tb == sb && c > t) v = 0.f; at[(32 * tb + t) * TROW + 32 * sb + c] = f2bf(v); }
        } else if (wid == 3) {
#pragma unroll
            for (int r = 0; r < 16; ++r) at[crow(r, hi) * TROW + 32 + c] = 0;
        }
        __syncthreads();
        f32x16 o[2]; o[0] = zero16(); o[1] = zero16();
        const bf16_t* sp = Sb + ((size_t)item * 256 + 32 * wid + c) * 128 + 8 * hi;
#pragma unroll
        for (int s = 0; s < 8; ++s) {
            const bf16x8 sf = *(const bf16x8*)(sp + 16 * s);
#pragma unroll
            for (int tb = 0; tb < 2; ++tb) { const bf16x8 qf = *(const bf16x8*)(hg + (size_t)(64 * ch + 32 * tb + c) * 3072 + 128 * h + 16 * s + 8 * hi); o[tb] = mfma32(sf, qf, o[tb]); }
        }
#pragma unroll
        for (int s = 0; s < 4; ++s) {
            const bf16x8 vf = *(const LAS bf16x8*)(vTl + (32 * wid + c) * TROW + (((2 * s + hi) ^ (((32 * wid + c) >> 3) & 7)) << 3));
#pragma unroll
            for (int tb = 0; tb < 2; ++tb) { const bf16x8 af = *(const LAS bf16x8*)(at + (32 * tb + c) * TROW + 16 * s + 8 * hi); o[tb] = mfma32(vf, af, o[tb]); }
        }
#pragma unroll
        for (int tb = 0; tb < 2; ++tb) { float ss = 0.f;
#pragma unroll
            for (int r = 0; r < 16; ++r) ss += o[tb][r] * o[tb][r];
            ss = xor32_sum(ss); if (hi == 0) red[wid * 64 + 32 * tb + c] = ss; }
        __syncthreads();
#pragma unroll
        for (int tb = 0; tb < 2; ++tb) {
            float tot = 0.f;
#pragma unroll
            for (int w8 = 0; w8 < 8; ++w8) tot += red[w8 * 64 + 32 * tb + c];
            const float rstd = rsqrtf(tot * (1.0f / 256.0f) + EPS); const size_t tok = (size_t)(64 * ch + 32 * tb + c);
#pragma unroll
            for (int g = 0; g < 4; ++g) {
                const int e0 = 32 * wid + 8 * g + 4 * hi;
                const s16x4 gv = *(const s16x4*)(hg + tok * 3072 + 2048 + 256 * h + e0); const f32x4 gg = *(const f32x4*)(gn + e0);
                float r4[4];
#pragma unroll
                for (int i = 0; i < 4; ++i) { const float gx = bf2f((bf16_t)gv[i]); const float sl = gx / (1.0f + expf(-gx)); r4[i] = o[tb][4 * g + i] * rstd * gg[i] * sl; }
                u32x2 wv; wv.x = cvt_pk_bf16(r4[0], r4[1]); wv.y = cvt_pk_bf16(r4[2], r4[3]); *(u32x2*)(y + tok * 1024 + 256 * h + e0) = wv;
            }
        }
        __syncthreads();
    }
}

#define XB_TMO      128
#define XB_XCNT(j)  (256  + 64 * (j))
#define XB_XSUB(j)  (1280 + 64 * (j))
#define XB_XGEN(j)  (2304 + 64 * (j))
#define XB_TOP      3328
#define XB_TOPGEN   3392
#define XCD_BAR_WORDS 3456
#define XB_SPIN_CAP (1u << 18)
__device__ __forceinline__ unsigned xb_ld(unsigned* p)              { return __hip_atomic_load(p, __ATOMIC_RELAXED, __HIP_MEMORY_SCOPE_AGENT); }
__device__ __forceinline__ unsigned xb_add(unsigned* p, unsigned v) { return __hip_atomic_fetch_add(p, v, __ATOMIC_RELAXED, __HIP_MEMORY_SCOPE_AGENT); }
__device__ __forceinline__ unsigned xb_xcc_id() { return (unsigned)__builtin_amdgcn_s_getreg((3 << 11) | 20) & 0xFu; }
#define XB_SPIN(cond, bar) do { unsigned _sp = 0; while (cond) { __builtin_amdgcn_s_sleep(1); \
    if ((++_sp & 255u) == 0u) { if (xb_ld(&(bar)[XB_TMO])) break; if (_sp > XB_SPIN_CAP) { atomicAdd(&(bar)[XB_TMO], 1u); break; } } } } while (0)
__device__ __forceinline__ void xcd_barrier_complete(unsigned* bar, unsigned x, unsigned& nloc, unsigned& nx) {
    const unsigned G = gridDim.x;
    unsigned sum, cnt, mine, sp = 0u;
    for (;;) {
        sum = 0u; cnt = 0u; mine = 0u;
#pragma unroll
        for (unsigned j = 0; j < 16; ++j) { const unsigned c = xb_ld(&bar[XB_XCNT(j)]); sum += c; cnt += (c > 0u) ? 1u : 0u; mine = (j == x) ? c : mine; }
        if (sum == G) break;
        __builtin_amdgcn_s_sleep(1);
        if ((++sp & 255u) == 0u) { if (xb_ld(&bar[XB_TMO])) break; if (sp > XB_SPIN_CAP) { atomicAdd(&bar[XB_TMO], 1u); break; } }
    }
    nloc = mine > 0u ? mine : 1u; nx = cnt > 0u ? cnt : 1u;
}
__device__ __forceinline__ void xcd_barrier(unsigned* bar, unsigned x, volatile LAS unsigned* st, int wv) {
    const int tid = opaque_tid(wv);
    asm volatile("s_waitcnt vmcnt(0)" ::: "memory");
    __syncthreads();
    if (tid == 0) {
        __builtin_amdgcn_s_waitcnt(0);
        unsigned nloc = st[0], nx = st[1];
        if (nloc == 0u) { xcd_barrier_complete(bar, x, nloc, nx); st[0] = nloc; st[1] = nx; }
        const unsigned old = xb_add(&bar[XB_XSUB(x)], 1u);
        const unsigned gen = old / nloc;
        if (old + 1u == (gen + 1u) * nloc) {
            __builtin_amdgcn_fence(__ATOMIC_RELEASE, "agent");
            asm volatile("s_waitcnt vmcnt(0)" ::: "memory");
            const unsigned og = xb_add(&bar[XB_TOP], 1u);
            const unsigned tg = og / nx;
            if (og + 1u == (tg + 1u) * nx) xb_add(&bar[XB_TOPGEN], 1u);
            else XB_SPIN(xb_ld(&bar[XB_TOPGEN]) == tg, bar);
            __builtin_amdgcn_fence(__ATOMIC_ACQUIRE, "agent");
            xb_add(&bar[XB_XGEN(x)], 1u);
            asm volatile("s_waitcnt vmcnt(0)" ::: "memory");
        } else {
            XB_SPIN(xb_ld(&bar[XB_XGEN(x)]) == gen, bar);
            __builtin_amdgcn_fence(__ATOMIC_ACQUIRE, "agent");
            asm volatile("s_waitcnt vmcnt(0)" ::: "memory");
        }
    }
    __syncthreads();
}
__global__ void __launch_bounds__(512) mk_fwd(Params p0) {
    extern __shared__ __attribute__((aligned(16))) unsigned char shm[];
    LAS unsigned char* lds = (LAS unsigned char*)shm;
    cg::grid_group grid = cg::this_grid();
    int ph = 0;
    const int wv = __builtin_amdgcn_readfirstlane((int)(threadIdx.x >> 6));
    if (p0.ph_lo < 0) grid.sync();
    volatile LAS unsigned* xst = (volatile LAS unsigned*)(lds + 132096);
    const unsigned xcc = xb_xcc_id();
    if (p0.ph_hi - p0.ph_lo > 1) {
        if (threadIdx.x == 0) { xst[0] = 0u; xst[1] = 0u; xb_add(&((unsigned*)(p0.ws + WS_BAR))[XB_XCNT(xcc)], 1u); }
        __syncthreads();
    }
    const int ph_lo = p0.ph_lo, ph_hi = p0.ph_hi;
#define hb ((bf16_t*)(p.ws + R_HB))
#define ssqkv ((float*)(p.ws + R_SSQKV))
#define ssqq ((float*)(p.ws + R_SSQQ))
#define qb ((bf16_t*)(p.ws + R_QB))
#define kn ((bf16_t*)(p.ws + R_KN))
#define vT ((bf16_t*)(p.ws + R_VT))
#define hg ((bf16_t*)(p.ws + R_HG))
#define ab ((float*)(p.ws + R_AB))
#define PHASE_BEGIN if (ph >= ph_lo && ph < ph_hi) { CParams* kp_ = (CParams*)__builtin_amdgcn_kernarg_segment_ptr(); asm volatile("" : "+s"(kp_)); CParams& p = *kp_;
#define PHASE_END   if (ph + 1 < ph_hi) xcd_barrier((unsigned*)(p.ws + WS_BAR), xcc, xst, wv); } ++ph;
#define xb ((bf16_t*)(p.ws + WS_XB))
#define ssqx ((float*)(p.ws + WS_SSQX))
#define invf ((const float*)(p.ws + WS_INVF))
#define wm ((bf16_t*)(p.ws + WS_WMIX))
#define wl ((bf16_t*)(p.ws + WS_WMLP))
    PHASE_BEGIN
        prologue_x(p, wv); conv_mixer(p, lds, 0, wv);
    PHASE_END
    auto layer_body = [&](auto LC) __attribute__((always_inline)) {
        constexpr int layer = decltype(LC)::value;
        constexpr int j = layer >> 1;
        if ((layer & 1) == 0) {
            PHASE_BEGIN
                EpiRow<M_MLAIN> E{hb, 768, ssqx, 4, 1.0f / 1024.0f, ssqkv, ssqq, nullptr, p.pos, invf};
                run_gemm(lds, xb, 1024, wm + WM_IN, 1024, S, 768, 1024, E, 0, wv);
                conv_mlp_weighted(p, lds, layer, wv, 192);
            PHASE_END
            PHASE_BEGIN
                { EpiRow<M_PLAIN> E{qb, 1536, ssqq, 2, 1.0f / 384.0f, nullptr, nullptr, nullptr, p.pos, invf};
                  run_gemm(lds, hb + 256, 768, wm + WM_UQ, 384, S, 1536, 384, E, 0, wv); }
                { EpiRow<M_PLAIN> E{kn, 1024, ssqkv, 1, 1.0f / 256.0f, nullptr, nullptr, nullptr, nullptr, nullptr};
                  run_gemm(lds, hb, 768, wm + WM_UK, 256, S, 1024, 256, E, 128, wv); }
                { EpiVT E{vT, ssqkv, 1.0f / 256.0f};
                  run_gemm(lds, wm + WM_UV, 256, hb, 768, 1024, S, 256, E, 128, wv); }
            PHASE_END
            PHASE_BEGIN
                attn_phase(p, lds, wv);
            PHASE_END
        } else {
            PHASE_BEGIN
                EpiRow<M_GLAIN> E{hg, 3072, ssqx, 4, 1.0f / 1024.0f, nullptr, nullptr, ab, nullptr, nullptr};
                run_gemm(lds, xb, 1024, wm + WM_IN, 1024, S, 3072, 1024, E, 0, wv);
                gla_gate_proj(p, lds, wv);
                conv_mlp(p, lds, layer, wv);
            PHASE_END
            PHASE_BEGIN
                gla_passA(p, lds, j, wv);
            PHASE_END
            PHASE_BEGIN
                gla_scan(p, wv);
            PHASE_END
            PHASE_BEGIN
                gla_passC(p, lds, j, wv);
            PHASE_END
        }
        PHASE_BEGIN
            const bool mla = (layer & 1) == 0;
            EpiRes E{xb, ssqx};
            run_gemm(lds, (const bf16_t*)(p.ws + (mla ? R_OB : R_Y)), 1024, wm + (mla ? WM_O_MLA : WM_O_GLA), 1024, S, 1024, 1024, E, 0, wv);
        PHASE_END
        PHASE_BEGIN
            EpiRow<M_SQRELU> E{(bf16_t*)(p.ws + R_HID), 4096, ssqx, 4, 1.0f / 1024.0f, nullptr, nullptr, nullptr, nullptr, nullptr};
            run_gemm(lds, xb, 1024, wl, 1024, S, 4096, 1024, E, 0, wv);
            if (layer < 3) conv_mixer(p, lds, layer + 1, wv);
        PHASE_END
        PHASE_BEGIN
            EpiRes E{xb, ssqx};
            run_gemm(lds, (const bf16_t*)(p.ws + R_HID), 4096, wl + (size_t)DFF * D, 4096, S, 1024, 4096, E, 0, wv);
        PHASE_END
    };
    layer_body(std::integral_constant<int, 0>{}); layer_body(std::integral_constant<int, 1>{}); layer_body(std::integral_constant<int, 2>{}); layer_body(std::integral_constant<int, 3>{});
    PHASE_BEGIN
        final_norm(p, wv);
    PHASE_END
}
#undef xb
#undef ssqx
#undef invf
#undef wm
#undef wl
#undef hb
#undef ssqkv
#undef ssqq
#undef qb
#undef kn
#undef vT
#undef hg
#undef ab
constexpr int N_PHASES = 1 + 2 * (4 + 2) + 2 * (5 + 2) + 1;

extern "C" void kernel_launch(void* const* d_in, const int* in_sizes, int n_in, void* d_out, int out_size, void* d_ws, size_t ws_size, hipStream_t stream) {
    static int grid = 0;
    if (grid == 0) {
        if (n_in != 18 || out_size != S * D || ws_size < WS_END) { fprintf(stderr, "kernel_launch: unexpected shapes (n_in %d out %d ws %zu need %zu)\n", n_in, out_size, ws_size, (size_t)WS_END); grid = -1; return; }
        int dev = 0, cus = 0, per_cu = 0;
        hipGetDevice(&dev); hipDeviceGetAttribute(&cus, hipDeviceAttributeMultiprocessorCount, dev);
        if (hipFuncSetAttribute((const void*)mk_fwd, hipFuncAttributeMaxDynamicSharedMemorySize, LDS_BYTES) != hipSuccess) { fprintf(stderr, "kernel_launch: hipFuncSetAttribute failed\n"); grid = -1; return; }
        if (hipOccupancyMaxActiveBlocksPerMultiprocessor(&per_cu, (const void*)mk_fwd, NTHR, LDS_BYTES) != hipSuccess || per_cu < 1) { fprintf(stderr, "kernel_launch: occupancy query gave %d\n", per_cu); per_cu = 1; }
        (void)hipGetLastError();
        grid = cus * per_cu;
        fprintf(stderr, "kernel_launch: grid %d (cus %d x %d)\n", grid, cus, per_cu);
    }
    if (grid < 0) return;
    Params p{};
    p.x = (const float*)d_in[0]; p.pos = (const int*)d_in[1]; p.norm_mix = (const float*)d_in[2]; p.norm_mlp = (const float*)d_in[3];
    p.mla_w_in = (const float*)d_in[4]; p.mla_q_norm = (const float*)d_in[5]; p.mla_w_uq = (const float*)d_in[6]; p.mla_kv_norm = (const float*)d_in[7];
    p.mla_w_ukv = (const float*)d_in[8]; p.mla_w_o = (const float*)d_in[9];
    p.gla_w_in = (const float*)d_in[10]; p.gla_w_gk_up = (const float*)d_in[11]; p.gla_b_gk = (const float*)d_in[12]; p.gla_g_norm = (const float*)d_in[13]; p.gla_w_o = (const float*)d_in[14];
    p.mlp_w_up = (const float*)d_in[15]; p.mlp_w_down = (const float*)d_in[16]; p.final_norm = (const float*)d_in[17];
    p.out = (float*)d_out; p.ws = (unsigned char*)d_ws;
#if N_LAUNCH_MODE == 1
    p.ph_lo = 0; p.ph_hi = N_PHASES;
    if (hipMemsetAsync((char*)d_ws + WS_BAR, 0, XCD_BAR_WORDS * 4, stream) != hipSuccess) { fprintf(stderr, "kernel_launch: memset of barrier words failed\n"); return; }
    void* args[] = {&p};
    hipError_t e = hipLaunchCooperativeKernel((const void*)mk_fwd, dim3(grid), dim3(NTHR), args, LDS_BYTES, stream);
    if (e != hipSuccess) fprintf(stderr, "cooperative launch failed: %s (grid %d)\n", hipGetErrorString(e), grid);
#else
    for (int ph = 0; ph < N_PHASES; ++ph) { p.ph_lo = ph; p.ph_hi = ph + 1; hipLaunchKernelGGL(mk_fwd, dim3(grid), dim3(NTHR), LDS_BYTES, stream, p); }
#endif
}
```

```cpp
#include <hip/hip_runtime.h>
#include <hip/hip_cooperative_groups.h>
#include <cstdio>
#include <type_traits>
namespace cg = cooperative_groups;

#define LAS __attribute__((address_space(3)))
typedef unsigned short bf16_t;
typedef short bf16x8 __attribute__((ext_vector_type(8)));
typedef short s16x4 __attribute__((ext_vector_type(4)));
typedef float f32x4 __attribute__((ext_vector_type(4)));
typedef float f32x16 __attribute__((ext_vector_type(16)));
typedef unsigned u32x4 __attribute__((ext_vector_type(4)));
typedef unsigned u32x2 __attribute__((ext_vector_type(2)));

#ifndef N_LAUNCH_MODE
#define N_LAUNCH_MODE 1
#endif

constexpr int S = 16384, D = 1024, DFF = 4096, NTHR = 512;
constexpr float EPS = 1e-6f;
constexpr int LDS_BYTES = 132096 + 1024;

constexpr size_t WS_XB = 0;
constexpr size_t WS_SSQX = WS_XB + (size_t)S * D * 2;
constexpr size_t WS_INVF = WS_SSQX + (size_t)S * 16 * 4;
constexpr size_t WS_BAR = WS_INVF + 1024;
constexpr size_t WS_WMIX = WS_BAR + 16384;
constexpr size_t WMIX_BYTES = (size_t)(3328 + 1024) * 1024 * 2;
constexpr size_t WS_WMLP = WS_WMIX + WMIX_BYTES;
constexpr size_t WS_R = WS_WMLP + (size_t)2 * DFF * D * 2;
constexpr size_t R_HB = WS_R;
constexpr size_t R_SSQKV = R_HB + (size_t)S * 768 * 2;
constexpr size_t R_SSQQ = R_SSQKV + (size_t)S * 16 * 4;
constexpr size_t R_QB = R_SSQQ + (size_t)S * 16 * 4;
constexpr size_t R_KN = R_QB + (size_t)S * 1536 * 2;
constexpr size_t R_VT = R_KN + (size_t)S * 1024 * 2;
constexpr size_t R_OB = R_VT + (size_t)S * 1024 * 2;
constexpr size_t R_MLA_END = R_OB + (size_t)S * 1024 * 2;
constexpr size_t R_HG = WS_R;
constexpr size_t R_AB = R_HG + (size_t)S * 3072 * 2;
constexpr size_t R_U = R_AB + (size_t)S * 16 * 4;
constexpr size_t R_DEC = R_U + (size_t)256 * 4 * 256 * 128 * 2;
constexpr size_t R_Y = R_DEC + (size_t)256 * 4 * 128 * 4;
constexpr size_t R_GLA_END = R_Y + (size_t)S * 1024 * 2;
constexpr size_t R_HID = WS_R;
constexpr size_t R_MLP_END = R_HID + (size_t)S * DFF * 2;
constexpr size_t WS_END = R_GLA_END > R_MLA_END ? (R_GLA_END > R_MLP_END ? R_GLA_END : R_MLP_END) : (R_MLA_END > R_MLP_END ? R_MLA_END : R_MLP_END);
constexpr size_t WM_IN = 0;
constexpr size_t WM_UQ = WM_IN + (size_t)768 * 1024;
constexpr size_t WM_UK = WM_UQ + (size_t)1536 * 384;
constexpr size_t WM_UV = WM_UK + (size_t)1024 * 256;
constexpr size_t WM_O_MLA = WM_UV + (size_t)1024 * 256;
constexpr size_t WM_O_GLA = (size_t)3328 * 1024;

struct Params {
    const float* x; const int* pos; const float* norm_mix; const float* norm_mlp;
    const float* mla_w_in; const float* mla_q_norm; const float* mla_w_uq; const float* mla_kv_norm; const float* mla_w_ukv; const float* mla_w_o;
    const float* gla_w_in; const float* gla_w_gk_up; const float* gla_b_gk; const float* gla_g_norm; const float* gla_w_o;
    const float* mlp_w_up; const float* mlp_w_down; const float* final_norm;
    float* out; unsigned char* ws;
    int ph_lo, ph_hi;
};

typedef const __attribute__((address_space(4))) Params CParams;
__device__ __forceinline__ bf16_t f2bf(float f) { unsigned u = __float_as_uint(f); u += 0x7FFFu + ((u >> 16) & 1u); return (bf16_t)(u >> 16); }
__device__ __forceinline__ float bf2f(bf16_t b) { return __uint_as_float(((unsigned)b) << 16); }
typedef __bf16 bf16v2_t __attribute__((ext_vector_type(2)));
__device__ __forceinline__ unsigned cvt_pk_bf16(float lo, float hi) { bf16v2_t v = {(__bf16)lo, (__bf16)hi}; return __builtin_bit_cast(unsigned, v); }
__device__ __forceinline__ bf16x8 pack8(f32x4 a, f32x4 b) { u32x4 w = {cvt_pk_bf16(a[0], a[1]), cvt_pk_bf16(a[2], a[3]), cvt_pk_bf16(b[0], b[1]), cvt_pk_bf16(b[2], b[3])}; return *reinterpret_cast<bf16x8*>(&w); }
__device__ __forceinline__ f32x16 mfma32(bf16x8 a, bf16x8 b, f32x16 c) { return __builtin_amdgcn_mfma_f32_32x32x16_bf16(a, b, c, 0, 0, 0); }
__device__ __forceinline__ int crow(int r, int hi) { return (r & 3) + 8 * (r >> 2) + 4 * hi; }
__device__ __forceinline__ f32x16 zero16() { f32x16 z; for (int i = 0; i < 16; ++i) z[i] = 0.f; return z; }
__device__ __forceinline__ int opaque_tid(int wv) { int l; asm volatile("v_mbcnt_lo_u32_b32 %0, -1, 0\n\tv_mbcnt_hi_u32_b32 %0, -1, %0" : "=v"(l)); return wv * 64 + l; }
__device__ __forceinline__ float xor16_sum(float x) { auto r = __builtin_amdgcn_permlane16_swap(__float_as_uint(x), __float_as_uint(x), false, false); return __uint_as_float(r[0]) + __uint_as_float(r[1]); }
__device__ __forceinline__ float xor32_sum(float x) { auto r = __builtin_amdgcn_permlane32_swap(__float_as_uint(x), __float_as_uint(x), false, false); return __uint_as_float(r[0]) + __uint_as_float(r[1]); }
__device__ __forceinline__ float xor32_max(float x) { auto r = __builtin_amdgcn_permlane32_swap(__float_as_uint(x), __float_as_uint(x), false, false); return fmaxf(__uint_as_float(r[0]), __uint_as_float(r[1])); }
__device__ __forceinline__ float xor16_max(float x) { auto r = __builtin_amdgcn_permlane16_swap(__float_as_uint(x), __float_as_uint(x), false, false); return fmaxf(__uint_as_float(r[0]), __uint_as_float(r[1])); }
__device__ __forceinline__ f32x4 mfma16(bf16x8 a, bf16x8 b, f32x4 c) { return __builtin_amdgcn_mfma_f32_16x16x32_bf16(a, b, c, 0, 0, 0); }
__device__ __forceinline__ float wave_sum(float x) {
    x = xor32_sum(x); x = xor16_sum(x);
    x += __uint_as_float(__builtin_amdgcn_ds_swizzle(__float_as_uint(x), 0x201F)); x += __uint_as_float(__builtin_amdgcn_ds_swizzle(__float_as_uint(x), 0x101F));
    x += __uint_as_float(__builtin_amdgcn_ds_swizzle(__float_as_uint(x), 0x081F)); x += __uint_as_float(__builtin_amdgcn_ds_swizzle(__float_as_uint(x), 0x041F));
    return x;
}
__device__ __forceinline__ void sincos_acc(float ang, float& sn, float& cs) {
    const double a = (double)ang * 0.63661977236758134308; const double q = __builtin_rint(a);
    const float x = (float)((a - q) * 1.57079632679489661923); const int qi = (int)q; const float x2 = x * x;
    const float s = x + x * x2 * (-1.6666654611e-1f + x2 * (8.3321608736e-3f + x2 * (-1.9515295891e-4f)));
    const float c = 1.0f - 0.5f * x2 + x2 * x2 * (4.166664568298827e-2f + x2 * (-1.388731625493765e-3f + x2 * 2.443315711809948e-5f));
    const int k = qi & 3;
    sn = (k == 0) ? s : (k == 1) ? c : (k == 2) ? -s : -c;
    cs = (k == 0) ? c : (k == 1) ? -s : (k == 2) ? -c : s;
}

namespace pg8 {
constexpr int BM = 256, BK = 64, HALF = 128, HTB = HALF * BK * 2, STAGE_BYTES = 8 * HTB, NXCD = 8, WGM = 8;
__device__ __forceinline__ int lds_byte(int r, int c) { const int st = (r >> 4) * 2 + (c >> 5), rr = r & 15, cc = c & 31, ob = rr * 64 + cc * 2; return st * 1024 + (ob ^ (((ob >> 9) & 1) << 5)); }
__device__ __forceinline__ void stage_rc(int b, int& R, int& C) { const int st = b / 1024, sb = b % 1024, swz = sb ^ (((sb >> 9) & 1) << 5); R = (st >> 1) * 16 + swz / 64; C = (st & 1) * 32 + (swz % 64) / 2; }
__device__ __forceinline__ int perm32(int rho) { const int n = rho >> 4, i = rho & 15; return 8 * (i >> 2) + 4 * n + (i & 3); }
struct Unit { int pm, pn; };
struct Gemm { const bf16_t* A; const bf16_t* Bt; int M, N, K, lda, ldb; };
struct StaticOrder {
    int nM, nN, nwg, G, c;
    __device__ void init(int M, int N, int G_, int c_) { nM = M / BM; nN = N / BM; nwg = nM * nN; G = G_; c = c_; }
    __device__ bool next(int i, Unit& u) const {
        const long L = (long)i * G + c; if (L >= nwg) return false;
        int wgid = (int)L; { const int q = nwg / NXCD, r = nwg % NXCD, xcd = wgid % NXCD, off = wgid / NXCD; wgid = (xcd < r ? xcd * (q + 1) : r * (q + 1) + (xcd - r) * q) + off; }
        const int nig = WGM * nN, gid = wgid / nig, fm = gid * WGM, gsz = (nM - fm) < WGM ? (nM - fm) : WGM;
        u.pm = fm + ((wgid % nig) % gsz); u.pn = (wgid % nig) / gsz; return true;
    }
};

template <class Epi>
__device__ __forceinline__ void gemm_phase(LAS unsigned char* lds, const Gemm g, const StaticOrder& S, const Epi& E, int wv) {
    const int tid = opaque_tid(wv), wid = __builtin_amdgcn_readfirstlane(tid >> 6), lane = tid & 63, wr = wid >> 2, wc = wid & 3, fr = lane & 15, fq = lane >> 4;
    const int K = g.K, nt = K / BK;
    unsigned voffA[2], voffB[2];
#pragma unroll
    for (int i = 0; i < 2; ++i) { int R, C; stage_rc(tid * 16 + i * 8192, R, C); const int Rb = Epi::PERM ? ((R & ~31) + perm32(R & 31)) : R;
        voffA[i] = (unsigned)(R * g.lda + C) * 2u; voffB[i] = (unsigned)(Rb * g.ldb + C) * 2u; }
    const size_t kstep = (size_t)(BK * 2);
    const size_t hstepA = (size_t)HALF * g.lda * 2, hstepB = (size_t)HALF * g.ldb * 2;
    const size_t tstepA = 2 * hstepA, tstepB = 2 * hstepB;
    const unsigned ldsw = (unsigned)wid * 1024u;
    const int aoff = lds_byte(wr * 64 + fr, fq * 8), boff = lds_byte(wc * 32 + fr, fq * 8);
#define PG8_SA(b, h) (((b) * 2 + (h)) * HTB)
#define PG8_SB(b, h) ((4 + (b) * 2 + (h)) * HTB)
#define PG8_STAGE(bufoff, gbase, voff) do { _Pragma("unroll") for (int _i = 0; _i < 2; ++_i) \
        __builtin_amdgcn_global_load_lds((const unsigned*)((const char*)(gbase) + (voff)[_i]), (LAS unsigned*)(lds + (bufoff) + ldsw + _i * 8192), 16, 0, 0); } while (0)
#define PG8_LDA(dst, b, h) do { _Pragma("unroll") for (int m = 0; m < 4; ++m) _Pragma("unroll") for (int k = 0; k < 2; ++k) dst[m][k] = *(const LAS bf16x8*)(lds + PG8_SA(b, h) + aoff + m * 2048 + k * 1024); } while (0)
#define PG8_LDB(dst, b, h) do { _Pragma("unroll") for (int n = 0; n < 2; ++n) _Pragma("unroll") for (int k = 0; k < 2; ++k) dst[n][k] = *(const LAS bf16x8*)(lds + PG8_SB(b, h) + boff + n * 2048 + k * 1024); } while (0)
#define PG8_MMA(ai, bj, At, Bt) do { __builtin_amdgcn_s_setprio(1); _Pragma("unroll") for (int m = 0; m < 4; ++m) _Pragma("unroll") for (int n = 0; n < 2; ++n) _Pragma("unroll") for (int k = 0; k < 2; ++k) \
        acc[ai][bj][m][n] = __builtin_amdgcn_mfma_f32_16x16x32_bf16(Bt[n][k], At[m][k], acc[ai][bj][m][n], 0, 0, 0); __builtin_amdgcn_s_setprio(0); } while (0)
#define PG8_WAIT_V(n) asm volatile("s_waitcnt vmcnt(" #n ")" ::: "memory")
#define PG8_WAIT_L(n) asm volatile("s_waitcnt lgkmcnt(" #n ")" ::: "memory")
#define PG8_BAR __builtin_amdgcn_s_barrier()
#define PG8_SCHED __builtin_amdgcn_sched_barrier(0)
    Unit cur, nxt; int ui = 0;
    if (!S.next(0, cur)) return;
    f32x4 acc[2][2][4][2];
    if constexpr (Epi::INIT) E.init(acc, cur, wr, wc, fr, fq); else {
#pragma unroll
    for (int a = 0; a < 2; ++a)
#pragma unroll
        for (int b = 0; b < 2; ++b)
#pragma unroll
            for (int m = 0; m < 4; ++m)
#pragma unroll
                for (int n = 0; n < 2; ++n) acc[a][b][m][n] = (f32x4){0.f, 0.f, 0.f, 0.f};
    }
    bf16x8 At[4][2], B0[2][2], B1[2][2];
    const char* cA = (const char*)g.A + (size_t)cur.pm * tstepA; const char* cB = (const char*)g.Bt + (size_t)cur.pn * tstepB;
    PG8_STAGE(PG8_SB(0, 0), cB, voffB); PG8_STAGE(PG8_SA(0, 0), cA, voffA); PG8_STAGE(PG8_SB(0, 1), cB + hstepB, voffB); PG8_STAGE(PG8_SA(0, 1), cA + hstepA, voffA);
    if (wr == 1) PG8_BAR;
    PG8_WAIT_V(4); PG8_BAR;
    PG8_STAGE(PG8_SB(1, 0), cB + kstep, voffB); PG8_STAGE(PG8_SA(1, 0), cA + kstep, voffA); PG8_STAGE(PG8_SB(1, 1), cB + hstepB + kstep, voffB);
    PG8_WAIT_V(6); PG8_BAR;
    for (;;) {
        const bool has_next = S.next(ui + 1, nxt);
        const char* nA = has_next ? (const char*)g.A + (size_t)nxt.pm * tstepA : cA; const char* nB = has_next ? (const char*)g.Bt + (size_t)nxt.pn * tstepB : cB;
        for (int t = 0; t < nt; t += 2) {
            const bool last = (t == nt - 2);
            const char* a1 = cA + (size_t)(t + 1) * kstep;
            const char* a2 = last ? nA : cA + (size_t)(t + 2) * kstep; const char* b2 = last ? nB : cB + (size_t)(t + 2) * kstep;
            const char* a3 = a2 + kstep; const char* b3 = b2 + kstep;
            PG8_LDB(B0, 0, 0); PG8_SCHED; PG8_LDA(At, 0, 0); PG8_STAGE(PG8_SA(1, 1), a1 + hstepA, voffA);
            PG8_WAIT_L(8); PG8_BAR; PG8_WAIT_L(0); PG8_MMA(0, 0, At, B0); PG8_BAR; PG8_SCHED;
            PG8_LDB(B1, 0, 1); PG8_STAGE(PG8_SB(0, 0), b2, voffB);
            PG8_BAR; PG8_WAIT_L(0); PG8_MMA(0, 1, At, B1); PG8_BAR;
            PG8_LDA(At, 0, 1); PG8_STAGE(PG8_SA(0, 0), a2, voffA);
            PG8_BAR; PG8_WAIT_L(0); PG8_MMA(1, 0, At, B0); PG8_BAR; PG8_SCHED;
            PG8_STAGE(PG8_SB(0, 1), b2 + hstepB, voffB);
            PG8_WAIT_V(6); PG8_BAR; PG8_MMA(1, 1, At, B1); PG8_BAR;
            PG8_LDB(B0, 1, 0); PG8_SCHED; PG8_LDA(At, 1, 0); PG8_STAGE(PG8_SA(0, 1), a2 + hstepA, voffA);
            PG8_WAIT_L(8); PG8_BAR; PG8_WAIT_L(0); PG8_MMA(0, 0, At, B0); PG8_BAR; PG8_SCHED;
            PG8_LDB(B1, 1, 1); PG8_STAGE(PG8_SB(1, 0), b3, voffB);
            PG8_BAR; PG8_WAIT_L(0); PG8_MMA(0, 1, At, B1); PG8_BAR;
            PG8_LDA(At, 1, 1); PG8_STAGE(PG8_SA(1, 0), a3, voffA);
            PG8_BAR; PG8_WAIT_L(0); PG8_MMA(1, 0, At, B0); PG8_BAR; PG8_SCHED;
            PG8_STAGE(PG8_SB(1, 1), b3 + hstepB, voffB);
            PG8_WAIT_V(6); PG8_BAR; PG8_MMA(1, 1, At, B1); PG8_BAR;
        }
        { int fr2 = fr, fq2 = fq, wr2 = wr, wc2 = wc; asm volatile("" : "+v"(fr2), "+v"(fq2), "+s"(wr2), "+s"(wc2)); E(acc, cur, wr2, wc2, fr2, fq2); }
        if (!has_next) break;
        if constexpr (Epi::INIT) E.init(acc, nxt, wr, wc, fr, fq); else {
#pragma unroll
        for (int a = 0; a < 2; ++a)
#pragma unroll
            for (int b = 0; b < 2; ++b)
#pragma unroll
                for (int m = 0; m < 4; ++m)
#pragma unroll
                    for (int n = 0; n < 2; ++n) acc[a][b][m][n] = (f32x4){0.f, 0.f, 0.f, 0.f};
        }
        cur = nxt; cA = nA; cB = nB; ++ui;
    }
    PG8_WAIT_V(0);
    if (wr == 0) PG8_BAR;
    PG8_BAR;
#undef PG8_SA
#undef PG8_SB
#undef PG8_STAGE
#undef PG8_LDA
#undef PG8_LDB
#undef PG8_MMA
#undef PG8_WAIT_V
#undef PG8_WAIT_L
#undef PG8_BAR
#undef PG8_SCHED
}
}
using pg8::Unit;

__device__ __forceinline__ void row_rstd(float (&rs)[2][4], const float* slots, int nslot4, float invK, int row0, int fq) {
#pragma unroll
    for (int ai = 0; ai < 2; ++ai)
#pragma unroll
        for (int m = 0; m < 4; ++m) {
            const int row = row0 + ai * 128 + m * 16; float s = 0.f;
            if (fq < nslot4) { const f32x4 v = *(const f32x4*)(slots + (size_t)row * 16 + 4 * fq); s = (v[0] + v[1]) + (v[2] + v[3]); }
            s = xor16_sum(s); s = xor32_sum(s);
            rs[ai][m] = rsqrtf(s * invK + EPS);
        }
}
__device__ __forceinline__ float sumsq4(f32x4 v) { return (v[0] * v[0] + v[1] * v[1]) + (v[2] * v[2] + v[3] * v[3]); }
__device__ __forceinline__ void rope8(f32x4& v0, f32x4& v1, int pos, int pair0, const float* invf) {
    const float fp = (float)pos; float sn, cs;
    sincos_acc(fp * invf[pair0 + 0], sn, cs); { const float a = v0[0], b = v0[1]; v0[0] = a * cs - b * sn; v0[1] = b * cs + a * sn; }
    sincos_acc(fp * invf[pair0 + 1], sn, cs); { const float a = v0[2], b = v0[3]; v0[2] = a * cs - b * sn; v0[3] = b * cs + a * sn; }
    sincos_acc(fp * invf[pair0 + 2], sn, cs); { const float a = v1[0], b = v1[1]; v1[0] = a * cs - b * sn; v1[1] = b * cs + a * sn; }
    sincos_acc(fp * invf[pair0 + 3], sn, cs); { const float a = v1[2], b = v1[3]; v1[2] = a * cs - b * sn; v1[3] = b * cs + a * sn; }
}
enum { M_MLAIN = 0, M_Q = 1, M_PLAIN = 2, M_GLAIN = 3, M_SQRELU = 4 };
template <int MODE> struct EpiRow {
    static constexpr bool PERM = true, INIT = false, LDSR = true;
    bf16_t* O; int ldc; const float* slots; int nslot4; float invK;
    float* ssq_a; float* ssq_b; float* abuf; const int* pos; const float* invf;
    const LAS float* lr; int pm0;
    __device__ __forceinline__ void operator()(const f32x4 (&acc)[2][2][4][2], const Unit& u, int wr, int wc, int fr, int fq) const {
        const int row0 = u.pm * 256 + wr * 64 + fr;
        float rs[2][4];
        if (u.pm == pm0) {
#pragma unroll
            for (int ai = 0; ai < 2; ++ai)
#pragma unroll
                for (int m = 0; m < 4; ++m) rs[ai][m] = lr[wr * 64 + fr + ai * 128 + m * 16];
        } else row_rstd(rs, slots, nslot4, invK, row0, fq);
        const int colw = u.pn * 256 + wc * 32;
#pragma unroll
        for (int ai = 0; ai < 2; ++ai)
#pragma unroll
            for (int m = 0; m < 4; ++m) {
                const int row = row0 + ai * 128 + m * 16; const float r = rs[ai][m];
                float ss0 = 0.f, ss1 = 0.f;
#pragma unroll
                for (int bj = 0; bj < 2; ++bj) {
                    f32x4 v0 = acc[ai][bj][m][0] * r, v1 = acc[ai][bj][m][1] * r;
                    const int col = colw + bj * 128 + 8 * fq;
                    if (MODE == M_MLAIN) {
                        const float q = sumsq4(v0) + sumsq4(v1); if (bj == 0) ss0 = q; else ss1 = q;
                        if (u.pn == 2 && bj == 1 && wc < 2) rope8(v0, v1, pos[row], (wc * 32 + 8 * fq) >> 1, invf);
                    }
                    if (MODE == M_SQRELU) {
#pragma unroll
                        for (int j = 0; j < 4; ++j) { const float a = fmaxf(v0[j], 0.f), b = fmaxf(v1[j], 0.f); v0[j] = a * a; v1[j] = b * b; }
                    }
                    if (MODE == M_GLAIN && u.pn == 12) {
                        if (bj == 0 && wc == 0 && fq < 2) { *(f32x4*)(abuf + (size_t)row * 16 + 8 * fq) = v0; *(f32x4*)(abuf + (size_t)row * 16 + 8 * fq + 4) = v1; }
                    } else {
                        u32x4 w; w.x = cvt_pk_bf16(v0[0], v0[1]); w.y = cvt_pk_bf16(v0[2], v0[3]); w.z = cvt_pk_bf16(v1[0], v1[1]); w.w = cvt_pk_bf16(v1[2], v1[3]);
                        *(u32x4*)(O + (size_t)row * ldc + col) = w;
                    }
                }
                if (MODE == M_MLAIN) {
                    float sa = (u.pn == 2) ? ss0 : ss0 + ss1;
                    sa = xor16_sum(sa); sa = xor32_sum(sa);
                    if (fq == 0) { if (u.pn == 0) ssq_a[(size_t)row * 16 + wc] = sa; else ssq_b[(size_t)row * 16 + (u.pn - 1) * 4 + wc] = sa; }
                }
            }
    }
};
struct EpiVT {
    static constexpr bool PERM = true, INIT = false, LDSR = false;
    bf16_t* O; const float* slots; float invK;
    __device__ __forceinline__ void operator()(const f32x4 (&acc)[2][2][4][2], const Unit& u, int wr, int wc, int fr, int fq) const {
        const int row0 = u.pm * 256 + wr * 64 + fr;
#pragma unroll
        for (int bj = 0; bj < 2; ++bj) {
            const int c0 = u.pn * 256 + bj * 128 + wc * 32 + 8 * fq; float rt[8];
#pragma unroll
            for (int t = 0; t < 8; ++t) { const f32x4 v = *(const f32x4*)(slots + (size_t)(c0 + t) * 16); rt[t] = rsqrtf(((v[0] + v[1]) + (v[2] + v[3])) * invK + EPS); }
#pragma unroll
            for (int ai = 0; ai < 2; ++ai)
#pragma unroll
                for (int m = 0; m < 4; ++m) {
                    const int row = row0 + ai * 128 + m * 16; const f32x4 v0 = acc[ai][bj][m][0], v1 = acc[ai][bj][m][1];
                    u32x4 w; w.x = cvt_pk_bf16(v0[0] * rt[0], v0[1] * rt[1]); w.y = cvt_pk_bf16(v0[2] * rt[2], v0[3] * rt[3]); w.z = cvt_pk_bf16(v1[0] * rt[4], v1[1] * rt[5]); w.w = cvt_pk_bf16(v1[2] * rt[6], v1[3] * rt[7]);
                    const int t0 = c0 & 31, pb = t0 >> 4, pw = (t0 >> 2) & 3; bf16_t* dst = O + (size_t)row * S + (c0 & ~31) + 4 * pb;
                    *(u32x2*)(dst + 8 * pw) = (u32x2){w.x, w.y}; *(u32x2*)(dst + 8 * (pw + 1)) = (u32x2){w.z, w.w};
                }
        }
    }
};
struct EpiRes {
    static constexpr bool PERM = true, INIT = true, LDSR = false;
    bf16_t* xb; float* ssq;
    __device__ __forceinline__ void init(f32x4 (&acc)[2][2][4][2], const Unit& u, int wr, int wc, int fr, int fq) const {
        const int row0 = u.pm * 256 + wr * 64 + fr, col0 = u.pn * 256 + wc * 32 + 8 * fq;
#pragma unroll
        for (int ai = 0; ai < 2; ++ai)
#pragma unroll
            for (int m = 0; m < 4; ++m)
#pragma unroll
                for (int bj = 0; bj < 2; ++bj) {
                    const bf16x8 old = *(const bf16x8*)(xb + (size_t)(row0 + ai * 128 + m * 16) * D + col0 + bj * 128);
#pragma unroll
                    for (int i = 0; i < 4; ++i) { acc[ai][bj][m][0][i] = bf2f((bf16_t)old[i]); acc[ai][bj][m][1][i] = bf2f((bf16_t)old[4 + i]); }
                }
    }
    __device__ __forceinline__ void operator()(const f32x4 (&acc)[2][2][4][2], const Unit& u, int wr, int wc, int fr, int fq) const {
        const int row0 = u.pm * 256 + wr * 64 + fr, col0 = u.pn * 256 + wc * 32 + 8 * fq;
#pragma unroll
        for (int ai = 0; ai < 2; ++ai)
#pragma unroll
            for (int m = 0; m < 4; ++m) {
                const int row = row0 + ai * 128 + m * 16; float ss = 0.f;
#pragma unroll
                for (int bj = 0; bj < 2; ++bj) {
                    const f32x4 o0 = acc[ai][bj][m][0], o1 = acc[ai][bj][m][1];
                    ss += sumsq4(o0) + sumsq4(o1);
                    *(bf16x8*)(xb + (size_t)row * D + col0 + bj * 128) = pack8(o0, o1);
                }
                ss = xor16_sum(ss); ss = xor32_sum(ss);
                if (fq == 0) ssq[(size_t)row * 16 + u.pn * 4 + wc] = ss;
            }
    }
};
template <class Epi> __device__ __forceinline__ void run_gemm(LAS unsigned char* lds, const bf16_t* A, int lda, const bf16_t* Bt, int ldb, int M, int N, int K, const Epi& E, int rot, int wv) {
    pg8::Gemm g{A, Bt, M, N, K, lda, ldb}; pg8::StaticOrder So; So.init(M, N, (int)gridDim.x, (int)((blockIdx.x + rot) % gridDim.x));
    if constexpr (Epi::LDSR) {
        Epi E2 = E; Unit u0; const bool has = So.next(0, u0); LAS float* lr = (LAS float*)(lds + 131072);
        if (has) { const int tid = opaque_tid(wv);
            if (tid < 256) { const float* sp = E.slots + (size_t)(u0.pm * 256 + tid) * 16; float s = 0.f;
                for (int i = 0; i < E.nslot4; ++i) { const f32x4 v = *(const f32x4*)(sp + 4 * i); s += (v[0] + v[1]) + (v[2] + v[3]); }
                lr[tid] = rsqrtf(s * E.invK + EPS); } }
        __syncthreads();
        E2.lr = lr; E2.pm0 = has ? u0.pm : -1;
        pg8::gemm_phase<Epi>(lds, g, So, E2, wv);
    } else pg8::gemm_phase<Epi>(lds, g, So, E, wv);
}

enum { CM_PLAIN = 0, CM_MLAIN = 1, CM_UQ = 2, CM_UK = 3, CM_UV = 4 };
__device__ __forceinline__ int colmap(int kind, int n, int Nsrc) {
    switch (kind) {
        case CM_MLAIN: { if (n < 256) return 384 + n; if (n < 640) return n - 256; if (n < 704) { const int j = n - 640; return 640 + (j >> 1) + 32 * (j & 1); } return -1; }
        case CM_UQ: { const int h = n / 192, r = n % 192; if (r < 128) return h * 192 + r; const int j = r - 128; return h * 192 + 128 + (j >> 1) + 32 * (j & 1); }
        case CM_UK: return (n >> 7) * 256 + (n & 127);
        case CM_UV: return (n >> 7) * 256 + 128 + (n & 127);
        default: return n < Nsrc ? n : -1;
    }
}
__device__ __forceinline__ void conv_w(LAS unsigned char* lds, int kind, const float* src, int K, int Nsrc, bf16_t* dst, int Ndst, const float* gain, float fac, int rot, int wv, int wgi, int nwgi) {
    LAS float* tile = (LAS float*)lds;
    const int tid = opaque_tid(wv), ntk = K / 64, ntn = Ndst / 64, nwg = nwgi, wg = (wgi + rot) % nwg;
    for (int t = wg; t < ntk * ntn; t += nwg) {
        const int kt = t % ntk, nt_ = t / ntk;
        const int nn = tid & 63, sc = colmap(kind, nt_ * 64 + nn, Nsrc);
#pragma unroll
        for (int j = 0; j < 8; ++j) { const int kk = (tid >> 6) + 8 * j, k = kt * 64 + kk; float v = 0.f; if (sc >= 0) { v = src[(size_t)k * Nsrc + sc] * fac; if (gain) v *= gain[k]; } tile[kk * 65 + nn] = v; }
        __syncthreads();
        { const int n = tid >> 3, k8 = (tid & 7) * 8; f32x4 a, b;
#pragma unroll
          for (int j = 0; j < 4; ++j) { a[j] = tile[(k8 + j) * 65 + n]; b[j] = tile[(k8 + 4 + j) * 65 + n]; }
          *(bf16x8*)(dst + (size_t)(nt_ * 64 + n) * K + kt * 64 + k8) = pack8(a, b); }
        __syncthreads();
    }
}
__device__ __forceinline__ void conv_plain(const float* src, int K, int Nsrc, bf16_t* dst, int Ndst, const float* gain, int rot, int wv, int wgi, int nwgi) {
    const int tid = opaque_tid(wv), lane = tid & 63, k8 = lane & 7, n4 = lane >> 3;
    const int ntk = K / 64, ntn = Ndst / 32, nw = nwgi * 8, w = ((wgi + rot) % nwgi) * 8 + (tid >> 6);
    for (int t = w; t < ntk * ntn; t += nw) {
        const int kt = t % ntk, nt_ = t / ntk, n = nt_ * 32 + 4 * n4, k = kt * 64 + 8 * k8;
        f32x4 v[8];
        if (n < Nsrc) {
#pragma unroll
            for (int i = 0; i < 8; ++i) v[i] = __builtin_nontemporal_load((const f32x4*)(src + (size_t)(k + i) * Nsrc + n));
            if (gain) {
                const f32x4 g0 = *(const f32x4*)(gain + k), g1 = *(const f32x4*)(gain + k + 4);
#pragma unroll
                for (int i = 0; i < 4; ++i) { v[i] *= g0[i]; v[4 + i] *= g1[i]; }
            }
        } else {
#pragma unroll
            for (int i = 0; i < 8; ++i) v[i] = (f32x4){0.f, 0.f, 0.f, 0.f};
        }
#pragma unroll
        for (int j = 0; j < 4; ++j)
            *(bf16x8*)(dst + (size_t)(n + j) * K + k) = pack8((f32x4){v[0][j], v[1][j], v[2][j], v[3][j]}, (f32x4){v[4][j], v[5][j], v[6][j], v[7][j]});
    }
}
struct ConvJob { int kind; const float* src; int K, Nsrc; bf16_t* dst; int Ndst; const float* gain; float fac; int rot; };
__device__ __forceinline__ bool get_job(CParams& p, int layer, int which, int ji, ConvJob& J) {
    bf16_t* wm = (bf16_t*)(p.ws + WS_WMIX); bf16_t* wl = (bf16_t*)(p.ws + WS_WMLP); const int j = layer >> 1;
    if (which == 1) {
        if (ji == 0) { J = ConvJob{CM_PLAIN, p.mlp_w_up + (size_t)layer * D * DFF, D, DFF, wl, DFF, p.norm_mlp + layer * D, 1.f, 0}; return true; }
        if (ji == 1) { J = ConvJob{CM_PLAIN, p.mlp_w_down + (size_t)layer * D * DFF, DFF, D, wl + (size_t)DFF * D, D, nullptr, 1.f, 0}; return true; }
        return false;
    }
    const float* gmix = p.norm_mix + layer * D;
    if ((layer & 1) == 0) {
        switch (ji) {
            case 0: J = ConvJob{CM_MLAIN, p.mla_w_in + (size_t)j * 1024 * 704, 1024, 704, wm + WM_IN, 768, gmix, 1.f, 0}; return true;
            case 1: J = ConvJob{CM_UQ, p.mla_w_uq + (size_t)j * 384 * 1536, 384, 1536, wm + WM_UQ, 1536, p.mla_q_norm + j * 384, 0.07216878364870323f * 1.4426950408889634f, 192}; return true;
            case 2: J = ConvJob{CM_UK, p.mla_w_ukv + (size_t)j * 256 * 2048, 256, 2048, wm + WM_UK, 1024, p.mla_kv_norm + j * 256, 1.f, 80}; return true;
            case 3: J = ConvJob{CM_UV, p.mla_w_ukv + (size_t)j * 256 * 2048, 256, 2048, wm + WM_UV, 1024, p.mla_kv_norm + j * 256, 1.f, 144}; return true;
            case 4: J = ConvJob{CM_PLAIN, p.mla_w_o + (size_t)j * 1024 * 1024, 1024, 1024, wm + WM_O_MLA, 1024, nullptr, 1.f, 208}; return true;
            default: return false;
        }
    } else {
        if (ji == 0) { J = ConvJob{CM_PLAIN, p.gla_w_in + (size_t)j * 1024 * 3088, 1024, 3088, wm + WM_IN, 3328, gmix, 1.f, 0}; return true; }
        if (ji == 1) { J = ConvJob{CM_PLAIN, p.gla_w_o + (size_t)j * 1024 * 1024, 1024, 1024, wm + WM_O_GLA, 1024, nullptr, 1.f, 64}; return true; }
        return false;
    }
}
__device__ __forceinline__ void conv_run(CParams& p, LAS unsigned char* lds, int layer, int which, int wv, int wgi, int nwgi) {
    for (int ji = 0; ji < 5; ++ji) { ConvJob J; if (!get_job(p, layer, which, ji, J)) break; if (J.kind == CM_PLAIN) conv_plain(J.src, J.K, J.Nsrc, J.dst, J.Ndst, J.gain, J.rot, wv, wgi, nwgi); else conv_w(lds, J.kind, J.src, J.K, J.Nsrc, J.dst, J.Ndst, J.gain, J.fac, J.rot, wv, wgi, nwgi); }
}
__device__ __forceinline__ void conv_mixer(CParams& p, LAS unsigned char* lds, int layer, int wv) { conv_run(p, lds, layer, 0, wv, (int)blockIdx.x, (int)gridDim.x); }
__device__ __forceinline__ void conv_mlp(CParams& p, LAS unsigned char* lds, int layer, int wv) { conv_run(p, lds, layer, 1, wv, (int)blockIdx.x, (int)gridDim.x); }
__device__ __forceinline__ void conv_mlp_weighted(CParams& p, LAS unsigned char* lds, int layer, int wv, int nbusy) {
    const int G = (int)gridDim.x, b = (int)blockIdx.x;
    if (nbusy >= G) { conv_run(p, lds, layer, 1, wv, b, G); return; }
    const int nv = nbusy + 3 * (G - nbusy);
    if (b < nbusy) conv_run(p, lds, layer, 1, wv, b, nv);
    else for (int t = 0; t < 3; ++t) conv_run(p, lds, layer, 1, wv, nbusy + 3 * (b - nbusy) + t, nv);
}

__device__ __forceinline__ void prologue_x(CParams& p, int wv) {
    const int tid = opaque_tid(wv), lane = tid & 63, gw = blockIdx.x * 8 + (tid >> 6), nw = gridDim.x * 8;
    bf16_t* xb = (bf16_t*)(p.ws + WS_XB); float* ssq = (float*)(p.ws + WS_SSQX);
    for (int row = gw; row < S; row += nw) {
        const float* xr = p.x + (size_t)row * D; float ss = 0.f;
#pragma unroll
        for (int i = 0; i < 4; ++i) { const f32x4 v = *(const f32x4*)(xr + i * 256 + lane * 4); ss += sumsq4(v); u32x2 w; w.x = cvt_pk_bf16(v[0], v[1]); w.y = cvt_pk_bf16(v[2], v[3]); *(u32x2*)(xb + (size_t)row * D + i * 256 + lane * 4) = w; }
        ss = wave_sum(ss);
        if (lane < 16) ssq[(size_t)row * 16 + lane] = (lane == 0) ? ss : 0.f;
    }
    if (blockIdx.x == 0 && tid < 32) { float* f = (float*)(p.ws + WS_INVF); f[tid] = 1.0f / powf(10000.0f, (float)(2 * tid) * (1.0f / 64.0f)); }
}
__device__ __forceinline__ void final_norm(CParams& p, int wv) {
    const int tid = opaque_tid(wv), lane = tid & 63, gw = blockIdx.x * 8 + (tid >> 6), nw = gridDim.x * 8;
    const bf16_t* xbp = (const bf16_t*)(p.ws + WS_XB);
    for (int row = gw; row < S; row += nw) {
        const bf16_t* xr = xbp + (size_t)row * D; float* orow = p.out + (size_t)row * D; f32x4 v[4]; float ss = 0.f;
#pragma unroll
        for (int i = 0; i < 2; ++i) { const bf16x8 t = *(const bf16x8*)(xr + i * 512 + lane * 8);
#pragma unroll
            for (int q = 0; q < 4; ++q) { v[2 * i][q] = bf2f((bf16_t)t[q]); v[2 * i + 1][q] = bf2f((bf16_t)t[4 + q]); }
            ss += sumsq4(v[2 * i]) + sumsq4(v[2 * i + 1]); }
        ss = wave_sum(ss);
        const float r = rsqrtf(ss * (1.0f / D) + EPS);
#pragma unroll
        for (int i = 0; i < 2; ++i) { const f32x4 g0 = *(const f32x4*)(p.final_norm + i * 512 + lane * 8), g1 = *(const f32x4*)(p.final_norm + i * 512 + lane * 8 + 4);
            *(f32x4*)(orow + i * 512 + lane * 8) = v[2 * i] * r * g0; *(f32x4*)(orow + i * 512 + lane * 8 + 4) = v[2 * i + 1] * r * g1; }
    }
}

constexpr int KROW = 400, VROW = 144, KTILE_B = 64 * KROW, VTILE_B = 128 * VROW, ATT_BUF = KTILE_B + VTILE_B;
__device__ __forceinline__ void attn_phase(CParams& p, LAS unsigned char* lds, int wv) {
    const int tid = opaque_tid(wv), wid = __builtin_amdgcn_readfirstlane(tid >> 6), lane_w = tid & 63;
    const bf16_t* qbp = (const bf16_t*)(p.ws + R_QB); bf16_t* ob = (bf16_t*)(p.ws + R_OB);
    for (int item = blockIdx.x; item < 256; item += gridDim.x) {
        const int h = item & 7, pr = item >> 3;
        for (int half = 0; half < 2; ++half) {
            int lane_o = lane_w; asm volatile("" : "+v"(lane_o));
            const int lane = lane_o, j16 = lane & 15, quad = lane >> 4, gsw = ((j16 >> 2) ^ (j16 >> 3)) & 1, kgx = quad ^ gsw;
            const int qblk = half == 0 ? 63 - pr : pr, ntile = 4 * qblk + 4;
            const int q0 = qblk * 256 + wid * 32, last_tile = (q0 + 31) >> 6;
            unsigned goff[6], gstr[6];
#pragma unroll
            for (int j = 0; j < 6; ++j) {
                const int g = (wid + 8 * j) * 64 + lane;
                if (g < 1600) { const int row = g / 25, sc = g % 25, cc = sc < 24 ? (sc ^ (((row >> 2) ^ (row >> 3)) & 1)) : 0;
                    if (cc >= 16) { goff[j] = (unsigned)R_HB + (unsigned)(row * 768 + 640 + (cc - 16) * 8) * 2u; gstr[j] = 64u * 768u * 2u; }
                    else { goff[j] = (unsigned)R_KN + (unsigned)(row * 1024 + h * 128 + cc * 8) * 2u; gstr[j] = 64u * 1024u * 2u; } }
                else { const int g2 = g - 1600, d = g2 / 9, sc = g2 % 9, cc = sc < 8 ? (sc ^ (((d >> 2) ^ (d >> 3)) & 1)) : 0;
                    goff[j] = (unsigned)R_VT + (unsigned)((h * 128 + d) * S + cc * 8) * 2u; gstr[j] = 128u; }
            }
            __builtin_amdgcn_sched_barrier(0);
            bf16x8 qf[2][6];
#pragma unroll
            for (int qb = 0; qb < 2; ++qb)
#pragma unroll
                for (int s = 0; s < 6; ++s) qf[qb][s] = *(const bf16x8*)(qbp + (size_t)(q0 + 16 * qb + j16) * 1536 + h * 192 + 32 * s + 8 * quad);
            { const float* invf = (const float*)(p.ws + WS_INVF);
#pragma unroll
              for (int qb = 0; qb < 2; ++qb) { const int qpos = p.pos[q0 + 16 * qb + j16];
#pragma unroll
                for (int s = 4; s < 6; ++s) {
                  f32x4 v0, v1; for (int i = 0; i < 4; ++i) { v0[i] = bf2f((bf16_t)qf[qb][s][i]); v1[i] = bf2f((bf16_t)qf[qb][s][4 + i]); }
                  rope8(v0, v1, qpos, 16 * (s - 4) + 4 * quad, invf); qf[qb][s] = pack8(v0, v1); __builtin_amdgcn_sched_barrier(0); } } }
            f32x4 o[8][2];
#pragma unroll
            for (int db = 0; db < 8; ++db) { o[db][0] = (f32x4){0.f, 0.f, 0.f, 0.f}; o[db][1] = (f32x4){0.f, 0.f, 0.f, 0.f}; }
            float mrun[2] = {0.f, 0.f}, lrun[2] = {0.f, 0.f};
            f32x4 negm[2] = {(f32x4){0.f, 0.f, 0.f, 0.f}, (f32x4){0.f, 0.f, 0.f, 0.f}};
            const int nld = wid < 3 ? 6 : 5;
#define ATT_ISSUE(slot_) do { _Pragma("unroll") for (int j = 0; j < 6; ++j) if (j < nld) { \
                __builtin_amdgcn_global_load_lds((const unsigned*)(p.ws + goff[j]), (LAS unsigned*)(lds + (slot_) * ATT_BUF + (wid + 8 * j) * 1024), 16, 0, 0); goff[j] += gstr[j]; } } while (0)
            ATT_ISSUE(0);
            if (ntile > 1) ATT_ISSUE(1);
            int slot = 0;
            for (int kt = 0; kt < ntile; ++kt) {
                const int cur = slot * ATT_BUF;
                if (kt + 1 < ntile) { if (wid < 3) asm volatile("s_waitcnt vmcnt(6)" ::: "memory"); else asm volatile("s_waitcnt vmcnt(5)" ::: "memory"); }
                else asm volatile("s_waitcnt vmcnt(0)" ::: "memory");
                __builtin_amdgcn_s_barrier();
                asm volatile("" ::: "memory");
                if (kt + 2 < ntile) { const int s2 = slot == 0 ? 2 : slot - 1; ATT_ISSUE(s2); }
                if (kt <= last_tile) {
                    f32x4 sa[4][2];
                    const LAS unsigned char* kbase = lds + cur + j16 * KROW + 16 * kgx;
#pragma unroll
                    for (int s = 0; s < 6; ++s)
#pragma unroll
                        for (int kb = 0; kb < 4; ++kb) {
                            const bf16x8 kf = *(const LAS bf16x8*)(kbase + kb * 16 * KROW + 64 * s);
                            sa[kb][0] = mfma16(kf, qf[0][s], s == 0 ? negm[0] : sa[kb][0]); sa[kb][1] = mfma16(kf, qf[1][s], s == 0 ? negm[1] : sa[kb][1]);
                        }
                    if (kt * 64 + 63 > q0) {
                        const float NEG = -__builtin_inff();
#pragma unroll
                        for (int qb = 0; qb < 2; ++qb) { const int dq = q0 + 16 * qb + j16 - kt * 64 - 4 * quad;
#pragma unroll
                            for (int kb = 0; kb < 4; ++kb)
#pragma unroll
                                for (int r = 0; r < 4; ++r) if (16 * kb + r > dq) sa[kb][qb][r] = NEG; }
                    }
                    float tmax[2];
#pragma unroll
                    for (int qb = 0; qb < 2; ++qb) { float m = sa[0][qb][0];
#pragma unroll
                        for (int kb = 0; kb < 4; ++kb)
#pragma unroll
                            for (int r = 0; r < 4; ++r) m = fmaxf(m, sa[kb][qb][r]);
                        tmax[qb] = xor16_max(xor32_max(m)); }
                    if (kt == 0 || __builtin_amdgcn_ballot_w64(tmax[0] > 8.0f || tmax[1] > 8.0f) != 0ull) {
#pragma unroll
                        for (int qb = 0; qb < 2; ++qb) { const float d = kt == 0 ? tmax[qb] : fmaxf(tmax[qb], 0.f), alpha = kt == 0 ? 1.0f : __builtin_amdgcn_exp2f(-d); mrun[qb] += d; lrun[qb] *= alpha;
                            negm[qb] = (f32x4){-mrun[qb], -mrun[qb], -mrun[qb], -mrun[qb]};
#pragma unroll
                            for (int kb = 0; kb < 4; ++kb) sa[kb][qb] -= d;
#pragma unroll
                            for (int db = 0; db < 8; ++db) o[db][qb] *= alpha; }
                    }
#pragma unroll
                    for (int qb = 0; qb < 2; ++qb) { float ps = 0.f;
#pragma unroll
                        for (int kb = 0; kb < 4; ++kb)
#pragma unroll
                            for (int r = 0; r < 4; ++r) { const float e = __builtin_amdgcn_exp2f(sa[kb][qb][r]); sa[kb][qb][r] = e; ps += e; }
                        lrun[qb] += ps; }
                    bf16x8 pfr[2][2];
#pragma unroll
                    for (int qb = 0; qb < 2; ++qb) { pfr[qb][0] = pack8(sa[0][qb], sa[1][qb]); pfr[qb][1] = pack8(sa[2][qb], sa[3][qb]); }
                    const LAS unsigned char* vbase = lds + cur + KTILE_B + j16 * VROW + 16 * kgx;
#pragma unroll
                    for (int ks = 0; ks < 2; ++ks)
#pragma unroll
                        for (int db = 0; db < 8; ++db) {
                            const bf16x8 vf = *(const LAS bf16x8*)(vbase + db * 16 * VROW + 64 * ks);
                            o[db][0] = mfma16(vf, pfr[0][ks], o[db][0]); o[db][1] = mfma16(vf, pfr[1][ks], o[db][1]);
                        }
                }
                slot = slot == 2 ? 0 : slot + 1;
            }
#undef ATT_ISSUE
            asm volatile("s_waitcnt lgkmcnt(0)" ::: "memory");
            __builtin_amdgcn_s_barrier();
            asm volatile("" ::: "memory");
#pragma unroll
            for (int qb = 0; qb < 2; ++qb) {
                const float l = xor16_sum(xor32_sum(lrun[qb])), inv = 1.0f / l;
                bf16_t* orow = ob + (size_t)(q0 + 16 * qb + j16) * 1024 + h * 128 + 4 * quad;
#pragma unroll
                for (int db = 0; db < 8; ++db) { u32x2 w; w.x = cvt_pk_bf16(o[db][qb][0] * inv, o[db][qb][1] * inv); w.y = cvt_pk_bf16(o[db][qb][2] * inv, o[db][qb][3] * inv); *(u32x2*)(orow + 16 * db) = w; }
            }
        }
    }
}

constexpr int TROW = 72;
__device__ __forceinline__ void stage_vT(LAS bf16_t* vTl, const bf16_t* hg, int c, int h, int wv) {
    const int tid = opaque_tid(wv);
#pragma unroll
    for (int j = 0; j < 4; ++j) { const int ch = tid + 512 * j, t = ch >> 5, e8 = (ch & 31) * 8;
        const bf16x8 v = *(const bf16x8*)(hg + (size_t)(64 * c + t) * 3072 + 1024 + 256 * h + e8);
#pragma unroll
        for (int i = 0; i < 8; ++i) vTl[(e8 + i) * TROW + (t ^ (((e8 >> 3) & 7) << 3))] = (bf16_t)v[i]; }
}
__device__ __forceinline__ void gla_gate_proj(CParams& p, LAS unsigned char* lds, int wv) {
    const int tid = opaque_tid(wv), wid = __builtin_amdgcn_readfirstlane(tid >> 6), lane = tid & 63, c = lane & 31, hi = lane >> 5;
    const bf16_t* xbp = (const bf16_t*)(p.ws + WS_XB); const bf16_t* wa = (const bf16_t*)(p.ws + WS_WMIX) + (size_t)3072 * 1024;
    const float* ssq = (const float*)(p.ws + WS_SSQX); float* ab = (float*)(p.ws + R_AB);
    LAS float* part = (LAS float*)lds;
    for (int blk = blockIdx.x; blk < S / 64; blk += gridDim.x) {
        const int r0 = blk * 64;
        f32x16 acc0 = zero16(), acc1 = zero16();
#pragma unroll
        for (int s = 0; s < 8; ++s) {
            const int ko = 16 * (wid * 8 + s) + 8 * hi;
            const bf16x8 b = *(const bf16x8*)(wa + (size_t)(c & 15) * 1024 + ko);
            const bf16x8 a0 = *(const bf16x8*)(xbp + (size_t)(r0 + c) * 1024 + ko), a1 = *(const bf16x8*)(xbp + (size_t)(r0 + 32 + c) * 1024 + ko);
            acc0 = mfma32(a0, b, acc0); acc1 = mfma32(a1, b, acc1);
        }
        if (c < 16) {
#pragma unroll
            for (int r = 0; r < 16; ++r) { part[(wid * 64 + crow(r, hi)) * 16 + c] = acc0[r]; part[(wid * 64 + 32 + crow(r, hi)) * 16 + c] = acc1[r]; }
        }
        __syncthreads();
#pragma unroll
        for (int jj = 0; jj < 2; ++jj) {
            const int idx = tid + 512 * jj, row = idx >> 4, col = idx & 15; float s = 0.f;
#pragma unroll
            for (int w8 = 0; w8 < 8; ++w8) s += part[(w8 * 64 + row) * 16 + col];
            float q = 0.f;
#pragma unroll
            for (int i = 0; i < 4; ++i) { const f32x4 v = *(const f32x4*)(ssq + (size_t)(r0 + row) * 16 + 4 * i); q += (v[0] + v[1]) + (v[2] + v[3]); }
            ab[(size_t)(r0 + row) * 16 + col] = s * rsqrtf(q * (1.0f / 1024.0f) + EPS);
        }
        __syncthreads();
    }
}
__device__ __forceinline__ void gla_passA(CParams& p, LAS unsigned char* lds, int j, int wv) {
    const int tid = opaque_tid(wv), wid = __builtin_amdgcn_readfirstlane(tid >> 6), lane = tid & 63, c = lane & 31, hi = lane >> 5;
    LAS bf16_t* kTl = (LAS bf16_t*)lds; LAS bf16_t* vTl = (LAS bf16_t*)(lds + 128 * TROW * 2); LAS float* tot = (LAS float*)(lds + (128 + 256) * TROW * 2);
    bf16_t* hg = (bf16_t*)(p.ws + R_HG); const float* ab = (const float*)(p.ws + R_AB); bf16_t* U = (bf16_t*)(p.ws + R_U); float* dec = (float*)(p.ws + R_DEC);
    const float* Wg = p.gla_w_gk_up + (size_t)j * 16 * 512; const float* bg = p.gla_b_gk + j * 512;
    for (int item = blockIdx.x; item < 1024; item += gridDim.x) {
        const int ch = item >> 2, h = item & 3, d = tid & 127, tg = tid >> 7;
        float w[16];
#pragma unroll
        for (int r = 0; r < 16; ++r) w[r] = Wg[r * 512 + 128 * h + d];
        const float bias = bg[128 * h + d];
        float cum[16]; float run = 0.f;
        const size_t ro0 = (size_t)(64 * ch + 16 * tg) * 3072 + 128 * h + d;
        bf16_t qraw[16], kraw[16];
#pragma unroll
        for (int tt = 0; tt < 16; ++tt) { qraw[tt] = hg[ro0 + (size_t)tt * 3072]; kraw[tt] = hg[ro0 + (size_t)tt * 3072 + 512]; }
#pragma unroll
        for (int tt = 0; tt < 16; ++tt) {
            const float* ar = ab + (size_t)(64 * ch + 16 * tg + tt) * 16; float z = bias;
#pragma unroll
            for (int r4 = 0; r4 < 4; ++r4) { const f32x4 a = *(const f32x4*)(ar + 4 * r4); z += a[0] * w[4 * r4] + a[1] * w[4 * r4 + 1] + a[2] * w[4 * r4 + 2] + a[3] * w[4 * r4 + 3]; }
            const float ls = fminf(z, 0.f) - __logf(1.0f + __expf(-fabsf(z)));
            run += ls * 0.0625f; cum[tt] = run;
        }
        tot[tg * 128 + d] = run;
        __syncthreads();
        float off = 0.f, total = 0.f;
#pragma unroll
        for (int g = 0; g < 4; ++g) { const float t_ = tot[g * 128 + d]; total += t_; if (g < tg) off += t_; }
#pragma unroll
        for (int tt = 0; tt < 16; ++tt) {
            const float b = cum[tt] + off; const size_t ro = ro0 + (size_t)tt * 3072;
            const float qv = bf2f(qraw[tt]), kv = bf2f(kraw[tt]);
            const float eb = __expf(b), enb = __expf(-b);
            hg[ro] = f2bf(qv * 0.08838834764831845f * eb);
            hg[ro + 512] = f2bf(kv * enb);
            kTl[d * TROW + 16 * tg + tt] = f2bf(kv * __expf(total - b));
        }
        if (tg == 0) dec[(size_t)item * 128 + d] = __expf(total);
        stage_vT(vTl, hg, ch, h, wv);
        __syncthreads();
        f32x16 acc[4]; for (int i = 0; i < 4; ++i) acc[i] = zero16();
#pragma unroll
        for (int s = 0; s < 4; ++s) {
            const bf16x8 bf = *(const LAS bf16x8*)(vTl + (32 * wid + c) * TROW + (((2 * s + hi) ^ (((32 * wid + c) >> 3) & 7)) << 3));
#pragma unroll
            for (int db = 0; db < 4; ++db) { const bf16x8 af = *(const LAS bf16x8*)(kTl + (32 * db + c) * TROW + 16 * s + 8 * hi); acc[db] = mfma32(af, bf, acc[db]); }
        }
        bf16_t* up = U + ((size_t)item * 256 + 32 * wid + c) * 128;
#pragma unroll
        for (int db = 0; db < 4; ++db)
#pragma unroll
            for (int g = 0; g < 4; ++g) { u32x2 wv; wv.x = cvt_pk_bf16(acc[db][4 * g], acc[db][4 * g + 1]); wv.y = cvt_pk_bf16(acc[db][4 * g + 2], acc[db][4 * g + 3]); *(u32x2*)(up + 32 * db + 8 * g + 4 * hi) = wv; }
        __syncthreads();
    }
}
__device__ __forceinline__ void gla_scan(CParams& p, int wv) {
    bf16_t* U = (bf16_t*)(p.ws + R_U); const float* dec = (const float*)(p.ws + R_DEC);
    const int tid = opaque_tid(wv);
    for (int idx = blockIdx.x * NTHR + tid; idx < 4 * 256 * 128; idx += gridDim.x * NTHR) {
        const int h = idx >> 15, rem = idx & 32767, d = rem & 127;
        bf16_t* up = U + (size_t)h * 32768 + rem; const float* dp = dec + h * 128 + d; float st = 0.f;
        for (int c0 = 0; c0 < 256; c0 += 32) {
            float u[32], dc[32];
#pragma unroll
            for (int i = 0; i < 32; ++i) { u[i] = bf2f(up[(size_t)(c0 + i) * 131072]); dc[i] = dp[(size_t)(c0 + i) * 512]; }
#pragma unroll
            for (int i = 0; i < 32; ++i) { up[(size_t)(c0 + i) * 131072] = f2bf(st); st = st * dc[i] + u[i]; }
        }
    }
}
__device__ __forceinline__ void gla_passC(CParams& p, LAS unsigned char* lds, int j, int wv) {
    const int tid = opaque_tid(wv), wid = __builtin_amdgcn_readfirstlane(tid >> 6), lane = tid & 63, c = lane & 31, hi = lane >> 5;
    LAS bf16_t* vTl = (LAS bf16_t*)lds; LAS bf16_t* at = (LAS bf16_t*)(lds + 256 * TROW * 2); LAS float* red = (LAS float*)(lds + (256 + 64) * TROW * 2);
    const bf16_t* hg = (const bf16_t*)(p.ws + R_HG); const bf16_t* Sb = (const bf16_t*)(p.ws + R_U); bf16_t* y = (bf16_t*)(p.ws + R_Y);
    const float* gn = p.gla_g_norm + j * 256;
    for (int item = blockIdx.x; item < 1024; item += gridDim.x) {
        const int ch = item >> 2, h = item & 3;
        stage_vT(vTl, hg, ch, h, wv);
        if (wid < 3) {
            const int tb = wid == 0 ? 0 : 1, sb = wid == 2 ? 1 : 0; f32x16 a = zero16();
#pragma unroll
            for (int s = 0; s < 8; ++s) {
                const bf16x8 qf = *(const bf16x8*)(hg + (size_t)(64 * ch + 32 * tb + c) * 3072 + 128 * h + 16 * s + 8 * hi);
                const bf16x8 kf = *(const bf16x8*)(hg + (size_t)(64 * ch + 32 * sb + c) * 3072 + 512 + 128 * h + 16 * s + 8 * hi);
                a = mfma32(qf, kf, a);
            }
#pragma unroll
            for (int r = 0; r < 16; ++r) { const int t = crow(r, hi); float v = a[r]; if (tb == sb && c > t) v = 0.f; at[(32 * tb + t) * TROW + 32 * sb + c] = f2bf(v); }
        } else if (wid == 3) {
#pragma unroll
            for (int r = 0; r < 16; ++r) at[crow(r, hi) * TROW + 32 + c] = 0;
        }
        __syncthreads();
        f32x16 o[2]; o[0] = zero16(); o[1] = zero16();
        const bf16_t* sp = Sb + ((size_t)item * 256 + 32 * wid + c) * 128 + 8 * hi;
#pragma unroll
        for (int s = 0; s < 8; ++s) {
            const bf16x8 sf = *(const bf16x8*)(sp + 16 * s);
#pragma unroll
            for (int tb = 0; tb < 2; ++tb) { const bf16x8 qf = *(const bf16x8*)(hg + (size_t)(64 * ch + 32 * tb + c) * 3072 + 128 * h + 16 * s + 8 * hi); o[tb] = mfma32(sf, qf, o[tb]); }
        }
#pragma unroll
        for (int s = 0; s < 4; ++s) {
            const bf16x8 vf = *(const LAS bf16x8*)(vTl + (32 * wid + c) * TROW + (((2 * s + hi) ^ (((32 * wid + c) >> 3) & 7)) << 3));
#pragma unroll
            for (int tb = 0; tb < 2; ++tb) { const bf16x8 af = *(const LAS bf16x8*)(at + (32 * tb + c) * TROW + 16 * s + 8 * hi); o[tb] = mfma32(vf, af, o[tb]); }
        }
#pragma unroll
        for (int tb = 0; tb < 2; ++tb) { float ss = 0.f;
#pragma unroll
            for (int r = 0; r < 16; ++r) ss += o[tb][r] * o[tb][r];
            ss = xor32_sum(ss); if (hi == 0) red[wid * 64 + 32 * tb + c] = ss; }
        __syncthreads();
#pragma unroll
        for (int tb = 0; tb < 2; ++tb) {
            float tot = 0.f;
#pragma unroll
            for (int w8 = 0; w8 < 8; ++w8) tot += red[w8 * 64 + 32 * tb + c];
            const float rstd = rsqrtf(tot * (1.0f / 256.0f) + EPS); const size_t tok = (size_t)(64 * ch + 32 * tb + c);
#pragma unroll
            for (int g = 0; g < 4; ++g) {
                const int e0 = 32 * wid + 8 * g + 4 * hi;
                const s16x4 gv = *(const s16x4*)(hg + tok * 3072 + 2048 + 256 * h + e0); const f32x4 gg = *(const f32x4*)(gn + e0);
                float r4[4];
#pragma unroll
                for (int i = 0; i < 4; ++i) { const float gx = bf2f((bf16_t)gv[i]); const float sl = gx / (1.0f + expf(-gx)); r4[i] = o[tb][4 * g + i] * rstd * gg[i] * sl; }
                u32x2 wv; wv.x = cvt_pk_bf16(r4[0], r4[1]); wv.y = cvt_pk_bf16(r4[2], r4[3]); *(u32x2*)(y + tok * 1024 + 256 * h + e0) = wv;
            }
        }
        __syncthreads();
    }
}

#define XB_TMO      128
#define XB_XCNT(j)  (256  + 64 * (j))
#define XB_XSUB(j)  (1280 + 64 * (j))
#define XB_XGEN(j)  (2304 + 64 * (j))
#define XB_TOP      3328
#define XB_TOPGEN   3392
#define XCD_BAR_WORDS 3456
#define XB_SPIN_CAP (1u << 18)
__device__ __forceinline__ unsigned xb_ld(unsigned* p)              { return __hip_atomic_load(p, __ATOMIC_RELAXED, __HIP_MEMORY_SCOPE_AGENT); }
__device__ __forceinline__ unsigned xb_add(unsigned* p, unsigned v) { return __hip_atomic_fetch_add(p, v, __ATOMIC_RELAXED, __HIP_MEMORY_SCOPE_AGENT); }
__device__ __forceinline__ unsigned xb_xcc_id() { return (unsigned)__builtin_amdgcn_s_getreg((3 << 11) | 20) & 0xFu; }
#define XB_SPIN(cond, bar) do { unsigned _sp = 0; while (cond) { __builtin_amdgcn_s_sleep(1); \
    if ((++_sp & 255u) == 0u) { if (xb_ld(&(bar)[XB_TMO])) break; if (_sp > XB_SPIN_CAP) { atomicAdd(&(bar)[XB_TMO], 1u); break; } } } } while (0)
__device__ __forceinline__ void xcd_barrier_complete(unsigned* bar, unsigned x, unsigned& nloc, unsigned& nx) {
    const unsigned G = gridDim.x;
    unsigned sum, cnt, mine, sp = 0u;
    for (;;) {
        sum = 0u; cnt = 0u; mine = 0u;
#pragma unroll
        for (unsigned j = 0; j < 16; ++j) { const unsigned c = xb_ld(&bar[XB_XCNT(j)]); sum += c; cnt += (c > 0u) ? 1u : 0u; mine = (j == x) ? c : mine; }
        if (sum == G) break;
        __builtin_amdgcn_s_sleep(1);
        if ((++sp & 255u) == 0u) { if (xb_ld(&bar[XB_TMO])) break; if (sp > XB_SPIN_CAP) { atomicAdd(&bar[XB_TMO], 1u); break; } }
    }
    nloc = mine > 0u ? mine : 1u; nx = cnt > 0u ? cnt : 1u;
}
__device__ __forceinline__ void xcd_barrier(unsigned* bar, unsigned x, volatile LAS unsigned* st, int wv) {
    const int tid = opaque_tid(wv);
    asm volatile("s_waitcnt vmcnt(0)" ::: "memory");
    __syncthreads();
    if (tid == 0) {
        __builtin_amdgcn_s_waitcnt(0);
        unsigned nloc = st[0], nx = st[1];
        if (nloc == 0u) { xcd_barrier_complete(bar, x, nloc, nx); st[0] = nloc; st[1] = nx; }
        const unsigned old = xb_add(&bar[XB_XSUB(x)], 1u);
        const unsigned gen = old / nloc;
        if (old + 1u == (gen + 1u) * nloc) {
            __builtin_amdgcn_fence(__ATOMIC_RELEASE, "agent");
            asm volatile("s_waitcnt vmcnt(0)" ::: "memory");
            const unsigned og = xb_add(&bar[XB_TOP], 1u);
            const unsigned tg = og / nx;
            if (og + 1u == (tg + 1u) * nx) xb_add(&bar[XB_TOPGEN], 1u);
            else XB_SPIN(xb_ld(&bar[XB_TOPGEN]) == tg, bar);
            __builtin_amdgcn_fence(__ATOMIC_ACQUIRE, "agent");
            xb_add(&bar[XB_XGEN(x)], 1u);
            asm volatile("s_waitcnt vmcnt(0)" ::: "memory");
        } else {
            XB_SPIN(xb_ld(&bar[XB_XGEN(x)]) == gen, bar);
            __builtin_amdgcn_fence(__ATOMIC_ACQUIRE, "agent");
            asm volatile("s_waitcnt vmcnt(0)" ::: "memory");
        }
    }
    __syncthreads();
}
__global__ void __launch_bounds__(512) mk_fwd(Params p0) {
    extern __shared__ __attribute__((aligned(16))) unsigned char shm[];
    LAS unsigned char* lds = (LAS unsigned char*)shm;
    cg::grid_group grid = cg::this_grid();
    int ph = 0;
    const int wv = __builtin_amdgcn_readfirstlane((int)(threadIdx.x >> 6));
    if (p0.ph_lo < 0) grid.sync();
    volatile LAS unsigned* xst = (volatile LAS unsigned*)(lds + 132096);
    const unsigned xcc = xb_xcc_id();
    if (p0.ph_hi - p0.ph_lo > 1) {
        if (threadIdx.x == 0) { xst[0] = 0u; xst[1] = 0u; xb_add(&((unsigned*)(p0.ws + WS_BAR))[XB_XCNT(xcc)], 1u); }
        __syncthreads();
    }
    const int ph_lo = p0.ph_lo, ph_hi = p0.ph_hi;
#define hb ((bf16_t*)(p.ws + R_HB))
#define ssqkv ((float*)(p.ws + R_SSQKV))
#define ssqq ((float*)(p.ws + R_SSQQ))
#define qb ((bf16_t*)(p.ws + R_QB))
#define kn ((bf16_t*)(p.ws + R_KN))
#define vT ((bf16_t*)(p.ws + R_VT))
#define hg ((bf16_t*)(p.ws + R_HG))
#define ab ((float*)(p.ws + R_AB))
#define PHASE_BEGIN if (ph >= ph_lo && ph < ph_hi) { CParams* kp_ = (CParams*)__builtin_amdgcn_kernarg_segment_ptr(); asm volatile("" : "+s"(kp_)); CParams& p = *kp_;
#define PHASE_END   if (ph + 1 < ph_hi) xcd_barrier((unsigned*)(p.ws + WS_BAR), xcc, xst, wv); } ++ph;
#define xb ((bf16_t*)(p.ws + WS_XB))
#define ssqx ((float*)(p.ws + WS_SSQX))
#define invf ((const float*)(p.ws + WS_INVF))
#define wm ((bf16_t*)(p.ws + WS_WMIX))
#define wl ((bf16_t*)(p.ws + WS_WMLP))
    PHASE_BEGIN
        prologue_x(p, wv); conv_mixer(p, lds, 0, wv);
    PHASE_END
    auto layer_body = [&](auto LC) __attribute__((always_inline)) {
        constexpr int layer = decltype(LC)::value;
        constexpr int j = layer >> 1;
        if ((layer & 1) == 0) {
            PHASE_BEGIN
                EpiRow<M_MLAIN> E{hb, 768, ssqx, 4, 1.0f / 1024.0f, ssqkv, ssqq, nullptr, p.pos, invf};
                run_gemm(lds, xb, 1024, wm + WM_IN, 1024, S, 768, 1024, E, 0, wv);
                conv_mlp_weighted(p, lds, layer, wv, 192);
            PHASE_END
            PHASE_BEGIN
                { EpiRow<M_PLAIN> E{qb, 1536, ssqq, 2, 1.0f / 384.0f, nullptr, nullptr, nullptr, p.pos, invf};
                  run_gemm(lds, hb + 256, 768, wm + WM_UQ, 384, S, 1536, 384, E, 0, wv); }
                { EpiRow<M_PLAIN> E{kn, 1024, ssqkv, 1, 1.0f / 256.0f, nullptr, nullptr, nullptr, nullptr, nullptr};
                  run_gemm(lds, hb, 768, wm + WM_UK, 256, S, 1024, 256, E, 128, wv); }
                { EpiVT E{vT, ssqkv, 1.0f / 256.0f};
                  run_gemm(lds, wm + WM_UV, 256, hb, 768, 1024, S, 256, E, 128, wv); }
            PHASE_END
            PHASE_BEGIN
                attn_phase(p, lds, wv);
            PHASE_END
        } else {
            PHASE_BEGIN
                EpiRow<M_GLAIN> E{hg, 3072, ssqx, 4, 1.0f / 1024.0f, nullptr, nullptr, ab, nullptr, nullptr};
                run_gemm(lds, xb, 1024, wm + WM_IN, 1024, S, 3072, 1024, E, 0, wv);
                gla_gate_proj(p, lds, wv);
                conv_mlp(p, lds, layer, wv);
            PHASE_END
            PHASE_BEGIN
                gla_passA(p, lds, j, wv);
            PHASE_END
            PHASE_BEGIN
                gla_scan(p, wv);
            PHASE_END
            PHASE_BEGIN
                gla_passC(p, lds, j, wv);
            PHASE_END
        }
        PHASE_BEGIN
            const bool mla = (layer & 1) == 0;
            EpiRes E{xb, ssqx};
            run_gemm(lds, (const bf16_t*)(p.ws + (mla ? R_OB : R_Y)), 1024, wm + (mla ? WM_O_MLA : WM_O_GLA), 1024, S, 1024, 1024, E, 0, wv);
        PHASE_END
        PHASE_BEGIN
            EpiRow<M_SQRELU> E{(bf16_t*)(p.ws + R_HID), 4096, ssqx, 4, 1.0f / 1024.0f, nullptr, nullptr, nullptr, nullptr, nullptr};
            run_gemm(lds, xb, 1024, wl, 1024, S, 4096, 1024, E, 0, wv);
            if (layer < 3) conv_mixer(p, lds, layer + 1, wv);
        PHASE_END
        PHASE_BEGIN
            EpiRes E{xb, ssqx};
            run_gemm(lds, (const bf16_t*)(p.ws + R_HID), 4096, wl + (size_t)DFF * D, 4096, S, 1024, 4096, E, 0, wv);
        PHASE_END
    };
    layer_body(std::integral_constant<int, 0>{}); layer_body(std::integral_constant<int, 1>{}); layer_body(std::integral_constant<int, 2>{}); layer_body(std::integral_constant<int, 3>{});
    PHASE_BEGIN
        final_norm(p, wv);
    PHASE_END
}
#undef xb
#undef ssqx
#undef invf
#undef wm
#undef wl
#undef hb
#undef ssqkv
#undef ssqq
#undef qb
#undef kn
#undef vT
#undef hg
#undef ab
constexpr int N_PHASES = 1 + 2 * (4 + 2) + 2 * (5 + 2) + 1;

extern "C" void kernel_launch(void* const* d_in, const int* in_sizes, int n_in, void* d_out, int out_size, void* d_ws, size_t ws_size, hipStream_t stream) {
    static int grid = 0;
    if (grid == 0) {
        if (n_in != 18 || out_size != S * D || ws_size < WS_END) { fprintf(stderr, "kernel_launch: unexpected shapes (n_in %d out %d ws %zu need %zu)\n", n_in, out_size, ws_size, (size_t)WS_END); grid = -1; return; }
        int dev = 0, cus = 0, per_cu = 0;
        hipGetDevice(&dev); hipDeviceGetAttribute(&cus, hipDeviceAttributeMultiprocessorCount, dev);
        if (hipFuncSetAttribute((const void*)mk_fwd, hipFuncAttributeMaxDynamicSharedMemorySize, LDS_BYTES) != hipSuccess) { fprintf(stderr, "kernel_launch: hipFuncSetAttribute failed\n"); grid = -1; return; }
        if (hipOccupancyMaxActiveBlocksPerMultiprocessor(&per_cu, (const void*)mk_fwd, NTHR, LDS_BYTES) != hipSuccess || per_cu < 1) { fprintf(stderr, "kernel_launch: occupancy query gave %d\n", per_cu); per_cu = 1; }
        (void)hipGetLastError();
        grid = cus * per_cu;
        fprintf(stderr, "kernel_launch: grid %d (cus %d x %d)\n", grid, cus, per_cu);
    }
    if (grid < 0) return;
    Params p{};
    p.x = (const float*)d_in[0]; p.pos = (const int*)d_in[1]; p.norm_mix = (const float*)d_in[2]; p.norm_mlp = (const float*)d_in[3];
    p.mla_w_in = (const float*)d_in[4]; p.mla_q_norm = (const float*)d_in[5]; p.mla_w_uq = (const float*)d_in[6]; p.mla_kv_norm = (const float*)d_in[7];
    p.mla_w_ukv = (const float*)d_in[8]; p.mla_w_o = (const float*)d_in[9];
    p.gla_w_in = (const float*)d_in[10]; p.gla_w_gk_up = (const float*)d_in[11]; p.gla_b_gk = (const float*)d_in[12]; p.gla_g_norm = (const float*)d_in[13]; p.gla_w_o = (const float*)d_in[14];
    p.mlp_w_up = (const float*)d_in[15]; p.mlp_w_down = (const float*)d_in[16]; p.final_norm = (const float*)d_in[17];
    p.out = (float*)d_out; p.ws = (unsigned char*)d_ws;
#if N_LAUNCH_MODE == 1
    p.ph_lo = 0; p.ph_hi = N_PHASES;
    if (hipMemsetAsync((char*)d_ws + WS_BAR, 0, XCD_BAR_WORDS * 4, stream) != hipSuccess) { fprintf(stderr, "kernel_launch: memset of barrier words failed\n"); return; }
    void* args[] = {&p};
    hipError_t e = hipLaunchCooperativeKernel((const void*)mk_fwd, dim3(grid), dim3(NTHR), args, LDS_BYTES, stream);
    if (e != hipSuccess) fprintf(stderr, "cooperative launch failed: %s (grid %d)\n", hipGetErrorString(e), grid);
#else
    for (int ph = 0; ph < N_PHASES; ++ph) { p.ph_lo = ph; p.ph_hi = ph + 1; hipLaunchKernelGGL(mk_fwd, dim3(grid), dim3(NTHR), LDS_BYTES, stream, p); }
#endif
}
```

```cpp
#include <hip/hip_runtime.h>
#include <hip/hip_cooperative_groups.h>
#include <cstdio>
#include <type_traits>
namespace cg = cooperative_groups;

#define LAS __attribute__((address_space(3)))
typedef unsigned short bf16_t;
typedef short bf16x8 __attribute__((ext_vector_type(8)));
typedef short s16x4 __attribute__((ext_vector_type(4)));
typedef float f32x4 __attribute__((ext_vector_type(4)));
typedef float f32x16 __attribute__((ext_vector_type(16)));
typedef unsigned u32x4 __attribute__((ext_vector_type(4)));
typedef unsigned u32x2 __attribute__((ext_vector_type(2)));

#ifndef N_LAUNCH_MODE
#define N_LAUNCH_MODE 1
#endif

constexpr int S = 16384, D = 1024, DFF = 4096, NTHR = 512;
constexpr float EPS = 1e-6f;
constexpr int LDS_BYTES = 132096 + 1024;

constexpr size_t WS_XB = 0;
constexpr size_t WS_SSQX = WS_XB + (size_t)S * D * 2;
constexpr size_t WS_INVF = WS_SSQX + (size_t)S * 16 * 4;
constexpr size_t WS_BAR = WS_INVF + 1024;
constexpr size_t WS_WMIX = WS_BAR + 16384;
constexpr size_t WMIX_BYTES = (size_t)(3328 + 1024) * 1024 * 2;
constexpr size_t WS_WMLP = WS_WMIX + WMIX_BYTES;
constexpr size_t WS_R = WS_WMLP + (size_t)2 * DFF * D * 2;
constexpr size_t R_HB = WS_R;
constexpr size_t R_SSQKV = R_HB + (size_t)S * 768 * 2;
constexpr size_t R_SSQQ = R_SSQKV + (size_t)S * 16 * 4;
constexpr size_t R_QB = R_SSQQ + (size_t)S * 16 * 4;
constexpr size_t R_KN = R_QB + (size_t)S * 1536 * 2;
constexpr size_t R_VT = R_KN + (size_t)S * 1024 * 2;
constexpr size_t R_OB = R_VT + (size_t)S * 1024 * 2;
constexpr size_t R_MLA_END = R_OB + (size_t)S * 1024 * 2;
constexpr size_t R_HG = WS_R;
constexpr size_t R_AB = R_HG + (size_t)S * 3072 * 2;
constexpr size_t R_U = R_AB + (size_t)S * 16 * 4;
constexpr size_t R_DEC = R_U + (size_t)256 * 4 * 256 * 128 * 2;
constexpr size_t R_Y = R_DEC + (size_t)256 * 4 * 128 * 4;
constexpr size_t R_GLA_END = R_Y + (size_t)S * 1024 * 2;
constexpr size_t R_HID = WS_R;
constexpr size_t R_MLP_END = R_HID + (size_t)S * DFF * 2;
constexpr size_t WS_END = R_GLA_END > R_MLA_END ? (R_GLA_END > R_MLP_END ? R_GLA_END : R_MLP_END) : (R_MLA_END > R_MLP_END ? R_MLA_END : R_MLP_END);
constexpr size_t WM_IN = 0;
constexpr size_t WM_UQ = WM_IN + (size_t)768 * 1024;
constexpr size_t WM_UK = WM_UQ + (size_t)1536 * 384;
constexpr size_t WM_UV = WM_UK + (size_t)1024 * 256;
constexpr size_t WM_O_MLA = WM_UV + (size_t)1024 * 256;
constexpr size_t WM_O_GLA = (size_t)3328 * 1024;

struct Params {
    const float* x; const int* pos; const float* norm_mix; const float* norm_mlp;
    const float* mla_w_in; const float* mla_q_norm; const float* mla_w_uq; const float* mla_kv_norm; const float* mla_w_ukv; const float* mla_w_o;
    const float* gla_w_in; const float* gla_w_gk_up; const float* gla_b_gk; const float* gla_g_norm; const float* gla_w_o;
    const float* mlp_w_up; const float* mlp_w_down; const float* final_norm;
    float* out; unsigned char* ws;
    int ph_lo, ph_hi;
};

typedef const __attribute__((address_space(4))) Params CParams;
__device__ __forceinline__ bf16_t f2bf(float f) { unsigned u = __float_as_uint(f); u += 0x7FFFu + ((u >> 16) & 1u); return (bf16_t)(u >> 16); }
__device__ __forceinline__ float bf2f(bf16_t b) { return __uint_as_float(((unsigned)b) << 16); }
typedef __bf16 bf16v2_t __attribute__((ext_vector_type(2)));
__device__ __forceinline__ unsigned cvt_pk_bf16(float lo, float hi) { bf16v2_t v = {(__bf16)lo, (__bf16)hi}; return __builtin_bit_cast(unsigned, v); }
__device__ __forceinline__ bf16x8 pack8(f32x4 a, f32x4 b) { u32x4 w = {cvt_pk_bf16(a[0], a[1]), cvt_pk_bf16(a[2], a[3]), cvt_pk_bf16(b[0], b[1]), cvt_pk_bf16(b[2], b[3])}; return *reinterpret_cast<bf16x8*>(&w); }
__device__ __forceinline__ f32x16 mfma32(bf16x8 a, bf16x8 b, f32x16 c) { return __builtin_amdgcn_mfma_f32_32x32x16_bf16(a, b, c, 0, 0, 0); }
__device__ __forceinline__ int crow(int r, int hi) { return (r & 3) + 8 * (r >> 2) + 4 * hi; }
__device__ __forceinline__ f32x16 zero16() { f32x16 z; for (int i = 0; i < 16; ++i) z[i] = 0.f; return z; }
__device__ __forceinline__ int opaque_tid(int wv) { int l; asm volatile("v_mbcnt_lo_u32_b32 %0, -1, 0\n\tv_mbcnt_hi_u32_b32 %0, -1, %0" : "=v"(l)); return wv * 64 + l; }
__device__ __forceinline__ float xor16_sum(float x) { auto r = __builtin_amdgcn_permlane16_swap(__float_as_uint(x), __float_as_uint(x), false, false); return __uint_as_float(r[0]) + __uint_as_float(r[1]); }
__device__ __forceinline__ float xor32_sum(float x) { auto r = __builtin_amdgcn_permlane32_swap(__float_as_uint(x), __float_as_uint(x), false, false); return __uint_as_float(r[0]) + __uint_as_float(r[1]); }
__device__ __forceinline__ float xor32_max(float x) { auto r = __builtin_amdgcn_permlane32_swap(__float_as_uint(x), __float_as_uint(x), false, false); return fmaxf(__uint_as_float(r[0]), __uint_as_float(r[1])); }
__device__ __forceinline__ float xor16_max(float x) { auto r = __builtin_amdgcn_permlane16_swap(__float_as_uint(x), __float_as_uint(x), false, false); return fmaxf(__uint_as_float(r[0]), __uint_as_float(r[1])); }
__device__ __forceinline__ f32x4 mfma16(bf16x8 a, bf16x8 b, f32x4 c) { return __builtin_amdgcn_mfma_f32_16x16x32_bf16(a, b, c, 0, 0, 0); }
__device__ __forceinline__ float wave_sum(float x) {
    x = xor32_sum(x); x = xor16_sum(x);
    x += __uint_as_float(__builtin_amdgcn_ds_swizzle(__float_as_uint(x), 0x201F)); x += __uint_as_float(__builtin_amdgcn_ds_swizzle(__float_as_uint(x), 0x101F));
    x += __uint_as_float(__builtin_amdgcn_ds_swizzle(__float_as_uint(x), 0x081F)); x += __uint_as_float(__builtin_amdgcn_ds_swizzle(__float_as_uint(x), 0x041F));
    return x;
}
__device__ __forceinline__ void sincos_acc(float ang, float& sn, float& cs) {
    const double a = (double)ang * 0.63661977236758134308; const double q = __builtin_rint(a);
    const float x = (float)((a - q) * 1.57079632679489661923); const int qi = (int)q; const float x2 = x * x;
    const float s = x + x * x2 * (-1.6666654611e-1f + x2 * (8.3321608736e-3f + x2 * (-1.9515295891e-4f)));
    const float c = 1.0f - 0.5f * x2 + x2 * x2 * (4.166664568298827e-2f + x2 * (-1.388731625493765e-3f + x2 * 2.443315711809948e-5f));
    const int k = qi & 3;
    sn = (k == 0) ? s : (k == 1) ? c : (k == 2) ? -s : -c;
    cs = (k == 0) ? c : (k == 1) ? -s : (k == 2) ? -c : s;
}

namespace pg8 {
constexpr int BM = 256, BK = 64, HALF = 128, HTB = HALF * BK * 2, STAGE_BYTES = 8 * HTB, NXCD = 8, WGM = 8;
__device__ __forceinline__ int lds_byte(int r, int c) { const int st = (r >> 4) * 2 + (c >> 5), rr = r & 15, cc = c & 31, ob = rr * 64 + cc * 2; return st * 1024 + (ob ^ (((ob >> 9) & 1) << 5)); }
__device__ __forceinline__ void stage_rc(int b, int& R, int& C) { const int st = b / 1024, sb = b % 1024, swz = sb ^ (((sb >> 9) & 1) << 5); R = (st >> 1) * 16 + swz / 64; C = (st & 1) * 32 + (swz % 64) / 2; }
__device__ __forceinline__ int perm32(int rho) { const int n = rho >> 4, i = rho & 15; return 8 * (i >> 2) + 4 * n + (i & 3); }
struct Unit { int pm, pn; };
struct Gemm { const bf16_t* A; const bf16_t* Bt; int M, N, K, lda, ldb; };
struct StaticOrder {
    int nM, nN, nwg, G, c;
    __device__ void init(int M, int N, int G_, int c_) { nM = M / BM; nN = N / BM; nwg = nM * nN; G = G_; c = c_; }
    __device__ bool next(int i, Unit& u) const {
        const long L = (long)i * G + c; if (L >= nwg) return false;
        int wgid = (int)L; { const int q = nwg / NXCD, r = nwg % NXCD, xcd = wgid % NXCD, off = wgid / NXCD; wgid = (xcd < r ? xcd * (q + 1) : r * (q + 1) + (xcd - r) * q) + off; }
        const int nig = WGM * nN, gid = wgid / nig, fm = gid * WGM, gsz = (nM - fm) < WGM ? (nM - fm) : WGM;
        u.pm = fm + ((wgid % nig) % gsz); u.pn = (wgid % nig) / gsz; return true;
    }
};

template <class Epi>
__device__ __forceinline__ void gemm_phase(LAS unsigned char* lds, const Gemm g, const StaticOrder& S, const Epi& E, int wv) {
    const int tid = opaque_tid(wv), wid = __builtin_amdgcn_readfirstlane(tid >> 6), lane = tid & 63, wr = wid >> 2, wc = wid & 3, fr = lane & 15, fq = lane >> 4;
    const int K = g.K, nt = K / BK;
    unsigned voffA[2], voffB[2];
#pragma unroll
    for (int i = 0; i < 2; ++i) { int R, C; stage_rc(tid * 16 + i * 8192, R, C); const int Rb = Epi::PERM ? ((R & ~31) + perm32(R & 31)) : R;
        voffA[i] = (unsigned)(R * g.lda + C) * 2u; voffB[i] = (unsigned)(Rb * g.ldb + C) * 2u; }
    const size_t kstep = (size_t)(BK * 2);
    const size_t hstepA = (size_t)HALF * g.lda * 2, hstepB = (size_t)HALF * g.ldb * 2;
    const size_t tstepA = 2 * hstepA, tstepB = 2 * hstepB;
    const unsigned ldsw = (unsigned)wid * 1024u;
    const int aoff = lds_byte(wr * 64 + fr, fq * 8), boff = lds_byte(wc * 32 + fr, fq * 8);
#define PG8_SA(b, h) (((b) * 2 + (h)) * HTB)
#define PG8_SB(b, h) ((4 + (b) * 2 + (h)) * HTB)
#define PG8_STAGE(bufoff, gbase, voff) do { _Pragma("unroll") for (int _i = 0; _i < 2; ++_i) \
        __builtin_amdgcn_global_load_lds((const unsigned*)((const char*)(gbase) + (voff)[_i]), (LAS unsigned*)(lds + (bufoff) + ldsw + _i * 8192), 16, 0, 0); } while (0)
#define PG8_LDA(dst, b, h) do { _Pragma("unroll") for (int m = 0; m < 4; ++m) _Pragma("unroll") for (int k = 0; k < 2; ++k) dst[m][k] = *(const LAS bf16x8*)(lds + PG8_SA(b, h) + aoff + m * 2048 + k * 1024); } while (0)
#define PG8_LDB(dst, b, h) do { _Pragma("unroll") for (int n = 0; n < 2; ++n) _Pragma("unroll") for (int k = 0; k < 2; ++k) dst[n][k] = *(const LAS bf16x8*)(lds + PG8_SB(b, h) + boff + n * 2048 + k * 1024); } while (0)
#define PG8_MMA(ai, bj, At, Bt) do { __builtin_amdgcn_s_setprio(1); _Pragma("unroll") for (int m = 0; m < 4; ++m) _Pragma("unroll") for (int n = 0; n < 2; ++n) _Pragma("unroll") for (int k = 0; k < 2; ++k) \
        acc[ai][bj][m][n] = __builtin_amdgcn_mfma_f32_16x16x32_bf16(Bt[n][k], At[m][k], acc[ai][bj][m][n], 0, 0, 0); __builtin_amdgcn_s_setprio(0); } while (0)
#define PG8_WAIT_V(n) asm volatile("s_waitcnt vmcnt(" #n ")" ::: "memory")
#define PG8_WAIT_L(n) asm volatile("s_waitcnt lgkmcnt(" #n ")" ::: "memory")
#define PG8_BAR __builtin_amdgcn_s_barrier()
#define PG8_SCHED __builtin_amdgcn_sched_barrier(0)
    Unit cur, nxt; int ui = 0;
    if (!S.next(0, cur)) return;
    f32x4 acc[2][2][4][2];
    if constexpr (Epi::INIT) E.init(acc, cur, wr, wc, fr, fq); else {
#pragma unroll
    for (int a = 0; a < 2; ++a)
#pragma unroll
        for (int b = 0; b < 2; ++b)
#pragma unroll
            for (int m = 0; m < 4; ++m)
#pragma unroll
                for (int n = 0; n < 2; ++n) acc[a][b][m][n] = (f32x4){0.f, 0.f, 0.f, 0.f};
    }
    bf16x8 At[4][2], B0[2][2], B1[2][2];
    const char* cA = (const char*)g.A + (size_t)cur.pm * tstepA; const char* cB = (const char*)g.Bt + (size_t)cur.pn * tstepB;
    PG8_STAGE(PG8_SB(0, 0), cB, voffB); PG8_STAGE(PG8_SA(0, 0), cA, voffA); PG8_STAGE(PG8_SB(0, 1), cB + hstepB, voffB); PG8_STAGE(PG8_SA(0, 1), cA + hstepA, voffA);
    if (wr == 1) PG8_BAR;
    PG8_WAIT_V(4); PG8_BAR;
    PG8_STAGE(PG8_SB(1, 0), cB + kstep, voffB); PG8_STAGE(PG8_SA(1, 0), cA + kstep, voffA); PG8_STAGE(PG8_SB(1, 1), cB + hstepB + kstep, voffB);
    PG8_WAIT_V(6); PG8_BAR;
    for (;;) {
        const bool has_next = S.next(ui + 1, nxt);
        const char* nA = has_next ? (const char*)g.A + (size_t)nxt.pm * tstepA : cA; const char* nB = has_next ? (const char*)g.Bt + (size_t)nxt.pn * tstepB : cB;
        for (int t = 0; t < nt; t += 2) {
            const bool last = (t == nt - 2);
            const char* a1 = cA + (size_t)(t + 1) * kstep;
            const char* a2 = last ? nA : cA + (size_t)(t + 2) * kstep; const char* b2 = last ? nB : cB + (size_t)(t + 2) * kstep;
            const char* a3 = a2 + kstep; const char* b3 = b2 + kstep;
            PG8_LDB(B0, 0, 0); PG8_SCHED; PG8_LDA(At, 0, 0); PG8_STAGE(PG8_SA(1, 1), a1 + hstepA, voffA);
            PG8_WAIT_L(8); PG8_BAR; PG8_WAIT_L(0); PG8_MMA(0, 0, At, B0); PG8_BAR; PG8_SCHED;
            PG8_LDB(B1, 0, 1); PG8_STAGE(PG8_SB(0, 0), b2, voffB);
            PG8_BAR; PG8_WAIT_L(0); PG8_MMA(0, 1, At, B1); PG8_BAR;
            PG8_LDA(At, 0, 1); PG8_STAGE(PG8_SA(0, 0), a2, voffA);
            PG8_BAR; PG8_WAIT_L(0); PG8_MMA(1, 0, At, B0); PG8_BAR; PG8_SCHED;
            PG8_STAGE(PG8_SB(0, 1), b2 + hstepB, voffB);
            PG8_WAIT_V(6); PG8_BAR; PG8_MMA(1, 1, At, B1); PG8_BAR;
            PG8_LDB(B0, 1, 0); PG8_SCHED; PG8_LDA(At, 1, 0); PG8_STAGE(PG8_SA(0, 1), a2 + hstepA, voffA);
            PG8_WAIT_L(8); PG8_BAR; PG8_WAIT_L(0); PG8_MMA(0, 0, At, B0); PG8_BAR; PG8_SCHED;
            PG8_LDB(B1, 1, 1); PG8_STAGE(PG8_SB(1, 0), b3, voffB);
            PG8_BAR; PG8_WAIT_L(0); PG8_MMA(0, 1, At, B1); PG8_BAR;
            PG8_LDA(At, 1, 1); PG8_STAGE(PG8_SA(1, 0), a3, voffA);
            PG8_BAR; PG8_WAIT_L(0); PG8_MMA(1, 0, At, B0); PG8_BAR; PG8_SCHED;
            PG8_STAGE(PG8_SB(1, 1), b3 + hstepB, voffB);
            PG8_WAIT_V(6); PG8_BAR; PG8_MMA(1, 1, At, B1); PG8_BAR;
        }
        { int fr2 = fr, fq2 = fq, wr2 = wr, wc2 = wc; asm volatile("" : "+v"(fr2), "+v"(fq2), "+s"(wr2), "+s"(wc2)); E(acc, cur, wr2, wc2, fr2, fq2); }
        if (!has_next) break;
        if constexpr (Epi::INIT) E.init(acc, nxt, wr, wc, fr, fq); else {
#pragma unroll
        for (int a = 0; a < 2; ++a)
#pragma unroll
            for (int b = 0; b < 2; ++b)
#pragma unroll
                for (int m = 0; m < 4; ++m)
#pragma unroll
                    for (int n = 0; n < 2; ++n) acc[a][b][m][n] = (f32x4){0.f, 0.f, 0.f, 0.f};
        }
        cur = nxt; cA = nA; cB = nB; ++ui;
    }
    PG8_WAIT_V(0);
    if (wr == 0) PG8_BAR;
    PG8_BAR;
#undef PG8_SA
#undef PG8_SB
#undef PG8_STAGE
#undef PG8_LDA
#undef PG8_LDB
#undef PG8_MMA
#undef PG8_WAIT_V
#undef PG8_WAIT_L
#undef PG8_BAR
#undef PG8_SCHED
}
}
using pg8::Unit;

__device__ __forceinline__ void row_rstd(float (&rs)[2][4], const float* slots, int nslot4, float invK, int row0, int fq) {
#pragma unroll
    for (int ai = 0; ai < 2; ++ai)
#pragma unroll
        for (int m = 0; m < 4; ++m) {
            const int row = row0 + ai * 128 + m * 16; float s = 0.f;
            if (fq < nslot4) { const f32x4 v = *(const f32x4*)(slots + (size_t)row * 16 + 4 * fq); s = (v[0] + v[1]) + (v[2] + v[3]); }
            s = xor16_sum(s); s = xor32_sum(s);
            rs[ai][m] = rsqrtf(s * invK + EPS);
        }
}
__device__ __forceinline__ float sumsq4(f32x4 v) { return (v[0] * v[0] + v[1] * v[1]) + (v[2] * v[2] + v[3] * v[3]); }
__device__ __forceinline__ void rope8(f32x4& v0, f32x4& v1, int pos, int pair0, const float* invf) {
    const float fp = (float)pos; float sn, cs;
    sincos_acc(fp * invf[pair0 + 0], sn, cs); { const float a = v0[0], b = v0[1]; v0[0] = a * cs - b * sn; v0[1] = b * cs + a * sn; }
    sincos_acc(fp * invf[pair0 + 1], sn, cs); { const float a = v0[2], b = v0[3]; v0[2] = a * cs - b * sn; v0[3] = b * cs + a * sn; }
    sincos_acc(fp * invf[pair0 + 2], sn, cs); { const float a = v1[0], b = v1[1]; v1[0] = a * cs - b * sn; v1[1] = b * cs + a * sn; }
    sincos_acc(fp * invf[pair0 + 3], sn, cs); { const float a = v1[2], b = v1[3]; v1[2] = a * cs - b * sn; v1[3] = b * cs + a * sn; }
}
enum { M_MLAIN = 0, M_Q = 1, M_PLAIN = 2, M_GLAIN = 3, M_SQRELU = 4 };
template <int MODE> struct EpiRow {
    static constexpr bool PERM = true, INIT = false, LDSR = true;
    bf16_t* O; int ldc; const float* slots; int nslot4; float invK;
    float* ssq_a; float* ssq_b; float* abuf; const int* pos; const float* invf;
    const LAS float* lr; int pm0;
    __device__ __forceinline__ void operator()(const f32x4 (&acc)[2][2][4][2], const Unit& u, int wr, int wc, int fr, int fq) const {
        const int row0 = u.pm * 256 + wr * 64 + fr;
        float rs[2][4];
        if (u.pm == pm0) {
#pragma unroll
            for (int ai = 0; ai < 2; ++ai)
#pragma unroll
                for (int m = 0; m < 4; ++m) rs[ai][m] = lr[wr * 64 + fr + ai * 128 + m * 16];
        } else row_rstd(rs, slots, nslot4, invK, row0, fq);
        const int colw = u.pn * 256 + wc * 32;
#pragma unroll
        for (int ai = 0; ai < 2; ++ai)
#pragma unroll
            for (int m = 0; m < 4; ++m) {
                const int row = row0 + ai * 128 + m * 16; const float r = rs[ai][m];
                float ss0 = 0.f, ss1 = 0.f;
#pragma unroll
                for (int bj = 0; bj < 2; ++bj) {
                    f32x4 v0 = acc[ai][bj][m][0] * r, v1 = acc[ai][bj][m][1] * r;
                    const int col = colw + bj * 128 + 8 * fq;
                    if (MODE == M_MLAIN) {
                        const float q = sumsq4(v0) + sumsq4(v1); if (bj == 0) ss0 = q; else ss1 = q;
                        if (u.pn == 2 && bj == 1 && wc < 2) rope8(v0, v1, pos[row], (wc * 32 + 8 * fq) >> 1, invf);
                    }
                    if (MODE == M_SQRELU) {
#pragma unroll
                        for (int j = 0; j < 4; ++j) { const float a = fmaxf(v0[j], 0.f), b = fmaxf(v1[j], 0.f); v0[j] = a * a; v1[j] = b * b; }
                    }
                    if (MODE == M_GLAIN && u.pn == 12) {
                        if (bj == 0 && wc == 0 && fq < 2) { *(f32x4*)(abuf + (size_t)row * 16 + 8 * fq) = v0; *(f32x4*)(abuf + (size_t)row * 16 + 8 * fq + 4) = v1; }
                    } else {
                        u32x4 w; w.x = cvt_pk_bf16(v0[0], v0[1]); w.y = cvt_pk_bf16(v0[2], v0[3]); w.z = cvt_pk_bf16(v1[0], v1[1]); w.w = cvt_pk_bf16(v1[2], v1[3]);
                        *(u32x4*)(O + (size_t)row * ldc + col) = w;
                    }
                }
                if (MODE == M_MLAIN) {
                    float sa = (u.pn == 2) ? ss0 : ss0 + ss1;
                    sa = xor16_sum(sa); sa = xor32_sum(sa);
                    if (fq == 0) { if (u.pn == 0) ssq_a[(size_t)row * 16 + wc] = sa; else ssq_b[(size_t)row * 16 + (u.pn - 1) * 4 + wc] = sa; }
                }
            }
    }
};
struct EpiVT {
    static constexpr bool PERM = true, INIT = false, LDSR = false;
    bf16_t* O; const float* slots; float invK;
    __device__ __forceinline__ void operator()(const f32x4 (&acc)[2][2][4][2], const Unit& u, int wr, int wc, int fr, int fq) const {
        const int row0 = u.pm * 256 + wr * 64 + fr;
#pragma unroll
        for (int bj = 0; bj < 2; ++bj) {
            const int c0 = u.pn * 256 + bj * 128 + wc * 32 + 8 * fq; float rt[8];
#pragma unroll
            for (int t = 0; t < 8; ++t) { const f32x4 v = *(const f32x4*)(slots + (size_t)(c0 + t) * 16); rt[t] = rsqrtf(((v[0] + v[1]) + (v[2] + v[3])) * invK + EPS); }
#pragma unroll
            for (int ai = 0; ai < 2; ++ai)
#pragma unroll
                for (int m = 0; m < 4; ++m) {
                    const int row = row0 + ai * 128 + m * 16; const f32x4 v0 = acc[ai][bj][m][0], v1 = acc[ai][bj][m][1];
                    u32x4 w; w.x = cvt_pk_bf16(v0[0] * rt[0], v0[1] * rt[1]); w.y = cvt_pk_bf16(v0[2] * rt[2], v0[3] * rt[3]); w.z = cvt_pk_bf16(v1[0] * rt[4], v1[1] * rt[5]); w.w = cvt_pk_bf16(v1[2] * rt[6], v1[3] * rt[7]);
                    const int t0 = c0 & 31, pb = t0 >> 4, pw = (t0 >> 2) & 3; bf16_t* dst = O + (size_t)row * S + (c0 & ~31) + 4 * pb;
                    *(u32x2*)(dst + 8 * pw) = (u32x2){w.x, w.y}; *(u32x2*)(dst + 8 * (pw + 1)) = (u32x2){w.z, w.w};
                }
        }
    }
};
struct EpiRes {
    static constexpr bool PERM = true, INIT = true, LDSR = false;
    bf16_t* xb; float* ssq;
    __device__ __forceinline__ void init(f32x4 (&acc)[2][2][4][2], const Unit& u, int wr, int wc, int fr, int fq) const {
        const int row0 = u.pm * 256 + wr * 64 + fr, col0 = u.pn * 256 + wc * 32 + 8 * fq;
#pragma unroll
        for (int ai = 0; ai < 2; ++ai)
#pragma unroll
            for (int m = 0; m < 4; ++m)
#pragma unroll
                for (int bj = 0; bj < 2; ++bj) {
                    const bf16x8 old = *(const bf16x8*)(xb + (size_t)(row0 + ai * 128 + m * 16) * D + col0 + bj * 128);
#pragma unroll
                    for (int i = 0; i < 4; ++i) { acc[ai][bj][m][0][i] = bf2f((bf16_t)old[i]); acc[ai][bj][m][1][i] = bf2f((bf16_t)old[4 + i]); }
                }
    }
    __device__ __forceinline__ void operator()(const f32x4 (&acc)[2][2][4][2], const Unit& u, int wr, int wc, int fr, int fq) const {
        const int row0 = u.pm * 256 + wr * 64 + fr, col0 = u.pn * 256 + wc * 32 + 8 * fq;
#pragma unroll
        for (int ai = 0; ai < 2; ++ai)
#pragma unroll
            for (int m = 0; m < 4; ++m) {
                const int row = row0 + ai * 128 + m * 16; float ss = 0.f;
#pragma unroll
                for (int bj = 0; bj < 2; ++bj) {
                    const f32x4 o0 = acc[ai][bj][m][0], o1 = acc[ai][bj][m][1];
                    ss += sumsq4(o0) + sumsq4(o1);
                    *(bf16x8*)(xb + (size_t)row * D + col0 + bj * 128) = pack8(o0, o1);
                }
                ss = xor16_sum(ss); ss = xor32_sum(ss);
                if (fq == 0) ssq[(size_t)row * 16 + u.pn * 4 + wc] = ss;
            }
    }
};
template <class Epi> __device__ __forceinline__ void run_gemm(LAS unsigned char* lds, const bf16_t* A, int lda, const bf16_t* Bt, int ldb, int M, int N, int K, const Epi& E, int rot, int wv) {
    pg8::Gemm g{A, Bt, M, N, K, lda, ldb}; pg8::StaticOrder So; So.init(M, N, (int)gridDim.x, (int)((blockIdx.x + rot) % gridDim.x));
    if constexpr (Epi::LDSR) {
        Epi E2 = E; Unit u0; const bool has = So.next(0, u0); LAS float* lr = (LAS float*)(lds + 131072);
        if (has) { const int tid = opaque_tid(wv);
            if (tid < 256) { const float* sp = E.slots + (size_t)(u0.pm * 256 + tid) * 16; float s = 0.f;
                for (int i = 0; i < E.nslot4; ++i) { const f32x4 v = *(const f32x4*)(sp + 4 * i); s += (v[0] + v[1]) + (v[2] + v[3]); }
                lr[tid] = rsqrtf(s * E.invK + EPS); } }
        __syncthreads();
        E2.lr = lr; E2.pm0 = has ? u0.pm : -1;
        pg8::gemm_phase<Epi>(lds, g, So, E2, wv);
    } else pg8::gemm_phase<Epi>(lds, g, So, E, wv);
}

enum { CM_PLAIN = 0, CM_MLAIN = 1, CM_UQ = 2, CM_UK = 3, CM_UV = 4 };
__device__ __forceinline__ int colmap(int kind, int n, int Nsrc) {
    switch (kind) {
        case CM_MLAIN: { if (n < 256) return 384 + n; if (n < 640) return n - 256; if (n < 704) { const int j = n - 640; return 640 + (j >> 1) + 32 * (j & 1); } return -1; }
        case CM_UQ: { const int h = n / 192, r = n % 192; if (r < 128) return h * 192 + r; const int j = r - 128; return h * 192 + 128 + (j >> 1) + 32 * (j & 1); }
        case CM_UK: return (n >> 7) * 256 + (n & 127);
        case CM_UV: return (n >> 7) * 256 + 128 + (n & 127);
        default: return n < Nsrc ? n : -1;
    }
}
__device__ __forceinline__ void conv_w(LAS unsigned char* lds, int kind, const float* src, int K, int Nsrc, bf16_t* dst, int Ndst, const float* gain, float fac, int rot, int wv, int wgi, int nwgi) {
    LAS float* tile = (LAS float*)lds;
    const int tid = opaque_tid(wv), ntk = K / 64, ntn = Ndst / 64, nwg = nwgi, wg = (wgi + rot) % nwg;
    for (int t = wg; t < ntk * ntn; t += nwg) {
        const int kt = t % ntk, nt_ = t / ntk;
        const int nn = tid & 63, sc = colmap(kind, nt_ * 64 + nn, Nsrc);
#pragma unroll
        for (int j = 0; j < 8; ++j) { const int kk = (tid >> 6) + 8 * j, k = kt * 64 + kk; float v = 0.f; if (sc >= 0) { v = src[(size_t)k * Nsrc + sc] * fac; if (gain) v *= gain[k]; } tile[kk * 65 + nn] = v; }
        __syncthreads();
        { const int n = tid >> 3, k8 = (tid & 7) * 8; f32x4 a, b;
#pragma unroll
          for (int j = 0; j < 4; ++j) { a[j] = tile[(k8 + j) * 65 + n]; b[j] = tile[(k8 + 4 + j) * 65 + n]; }
          *(bf16x8*)(dst + (size_t)(nt_ * 64 + n) * K + kt * 64 + k8) = pack8(a, b); }
        __syncthreads();
    }
}
__device__ __forceinline__ void conv_plain(const float* src, int K, int Nsrc, bf16_t* dst, int Ndst, const float* gain, int rot, int wv, int wgi, int nwgi) {
    const int tid = opaque_tid(wv), lane = tid & 63, k8 = lane & 7, n4 = lane >> 3;
    const int ntk = K / 64, ntn = Ndst / 32, nw = nwgi * 8, w = ((wgi + rot) % nwgi) * 8 + (tid >> 6);
    for (int t = w; t < ntk * ntn; t += nw) {
        const int kt = t % ntk, nt_ = t / ntk, n = nt_ * 32 + 4 * n4, k = kt * 64 + 8 * k8;
        f32x4 v[8];
        if (n < Nsrc) {
#pragma unroll
            for (int i = 0; i < 8; ++i) v[i] = __builtin_nontemporal_load((const f32x4*)(src + (size_t)(k + i) * Nsrc + n));
            if (gain) {
                const f32x4 g0 = *(const f32x4*)(gain + k), g1 = *(const f32x4*)(gain + k + 4);
#pragma unroll
                for (int i = 0; i < 4; ++i) { v[i] *= g0[i]; v[4 + i] *= g1[i]; }
            }
        } else {
#pragma unroll
            for (int i = 0; i < 8; ++i) v[i] = (f32x4){0.f, 0.f, 0.f, 0.f};
        }
#pragma unroll
        for (int j = 0; j < 4; ++j)
            *(bf16x8*)(dst + (size_t)(n + j) * K + k) = pack8((f32x4){v[0][j], v[1][j], v[2][j], v[3][j]}, (f32x4){v[4][j], v[5][j], v[6][j], v[7][j]});
    }
}
struct ConvJob { int kind; const float* src; int K, Nsrc; bf16_t* dst; int Ndst; const float* gain; float fac; int rot; };
__device__ __forceinline__ bool get_job(CParams& p, int layer, int which, int ji, ConvJob& J) {
    bf16_t* wm = (bf16_t*)(p.ws + WS_WMIX); bf16_t* wl = (bf16_t*)(p.ws + WS_WMLP); const int j = layer >> 1;
    if (which == 1) {
        if (ji == 0) { J = ConvJob{CM_PLAIN, p.mlp_w_up + (size_t)layer * D * DFF, D, DFF, wl, DFF, p.norm_mlp + layer * D, 1.f, 0}; return true; }
        if (ji == 1) { J = ConvJob{CM_PLAIN, p.mlp_w_down + (size_t)layer * D * DFF, DFF, D, wl + (size_t)DFF * D, D, nullptr, 1.f, 0}; return true; }
        return false;
    }
    const float* gmix = p.norm_mix + layer * D;
    if ((layer & 1) == 0) {
        switch (ji) {
            case 0: J = ConvJob{CM_MLAIN, p.mla_w_in + (size_t)j * 1024 * 704, 1024, 704, wm + WM_IN, 768, gmix, 1.f, 0}; return true;
            case 1: J = ConvJob{CM_UQ, p.mla_w_uq + (size_t)j * 384 * 1536, 384, 1536, wm + WM_UQ, 1536, p.mla_q_norm + j * 384, 0.07216878364870323f * 1.4426950408889634f, 192}; return true;
            case 2: J = ConvJob{CM_UK, p.mla_w_ukv + (size_t)j * 256 * 2048, 256, 2048, wm + WM_UK, 1024, p.mla_kv_norm + j * 256, 1.f, 80}; return true;
            case 3: J = ConvJob{CM_UV, p.mla_w_ukv + (size_t)j * 256 * 2048, 256, 2048, wm + WM_UV, 1024, p.mla_kv_norm + j * 256, 1.f, 144}; return true;
            case 4: J = ConvJob{CM_PLAIN, p.mla_w_o + (size_t)j * 1024 * 1024, 1024, 1024, wm + WM_O_MLA, 1024, nullptr, 1.f, 208}; return true;
            default: return false;
        }
    } else {
        if (ji == 0) { J = ConvJob{CM_PLAIN, p.gla_w_in + (size_t)j * 1024 * 3088, 1024, 3088, wm + WM_IN, 3328, gmix, 1.f, 0}; return true; }
        if (ji == 1) { J = ConvJob{CM_PLAIN, p.gla_w_o + (size_t)j * 1024 * 1024, 1024, 1024, wm + WM_O_GLA, 1024, nullptr, 1.f, 64}; return true; }
        return false;
    }
}
__device__ __forceinline__ void conv_run(CParams& p, LAS unsigned char* lds, int layer, int which, int wv, int wgi, int nwgi) {
    for (int ji = 0; ji < 5; ++ji) { ConvJob J; if (!get_job(p, layer, which, ji, J)) break; if (J.kind == CM_PLAIN) conv_plain(J.src, J.K, J.Nsrc, J.dst, J.Ndst, J.gain, J.rot, wv, wgi, nwgi); else conv_w(lds, J.kind, J.src, J.K, J.Nsrc, J.dst, J.Ndst, J.gain, J.fac, J.rot, wv, wgi, nwgi); }
}
__device__ __forceinline__ void conv_mixer(CParams& p, LAS unsigned char* lds, int layer, int wv) { conv_run(p, lds, layer, 0, wv, (int)blockIdx.x, (int)gridDim.x); }
__device__ __forceinline__ void conv_mlp(CParams& p, LAS unsigned char* lds, int layer, int wv) { conv_run(p, lds, layer, 1, wv, (int)blockIdx.x, (int)gridDim.x); }
__device__ __forceinline__ void conv_mlp_weighted(CParams& p, LAS unsigned char* lds, int layer, int wv, int nbusy) {
    const int G = (int)gridDim.x, b = (int)blockIdx.x;
    if (nbusy >= G) { conv_run(p, lds, layer, 1, wv, b, G); return; }
    const int nv = nbusy + 3 * (G - nbusy);
    if (b < nbusy) conv_run(p, lds, layer, 1, wv, b, nv);
    else for (int t = 0; t < 3; ++t) conv_run(p, lds, layer, 1, wv, nbusy + 3 * (b - nbusy) + t, nv);
}

__device__ __forceinline__ void prologue_x(CParams& p, int wv) {
    const int tid = opaque_tid(wv), lane = tid & 63, gw = blockIdx.x * 8 + (tid >> 6), nw = gridDim.x * 8;
    bf16_t* xb = (bf16_t*)(p.ws + WS_XB); float* ssq = (float*)(p.ws + WS_SSQX);
    for (int row = gw; row < S; row += nw) {
        const float* xr = p.x + (size_t)row * D; float ss = 0.f;
#pragma unroll
        for (int i = 0; i < 4; ++i) { const f32x4 v = *(const f32x4*)(xr + i * 256 + lane * 4); ss += sumsq4(v); u32x2 w; w.x = cvt_pk_bf16(v[0], v[1]); w.y = cvt_pk_bf16(v[2], v[3]); *(u32x2*)(xb + (size_t)row * D + i * 256 + lane * 4) = w; }
        ss = wave_sum(ss);
        if (lane < 16) ssq[(size_t)row * 16 + lane] = (lane == 0) ? ss : 0.f;
    }
    if (blockIdx.x == 0 && tid < 32) { float* f = (float*)(p.ws + WS_INVF); f[tid] = 1.0f / powf(10000.0f, (float)(2 * tid) * (1.0f / 64.0f)); }
}
__device__ __forceinline__ void final_norm(CParams& p, int wv) {
    const int tid = opaque_tid(wv), lane = tid & 63, gw = blockIdx.x * 8 + (tid >> 6), nw = gridDim.x * 8;
    const bf16_t* xbp = (const bf16_t*)(p.ws + WS_XB);
    for (int row = gw; row < S; row += nw) {
        const bf16_t* xr = xbp + (size_t)row * D; float* orow = p.out + (size_t)row * D; f32x4 v[4]; float ss = 0.f;
#pragma unroll
        for (int i = 0; i < 2; ++i) { const bf16x8 t = *(const bf16x8*)(xr + i * 512 + lane * 8);
#pragma unroll
            for (int q = 0; q < 4; ++q) { v[2 * i][q] = bf2f((bf16_t)t[q]); v[2 * i + 1][q] = bf2f((bf16_t)t[4 + q]); }
            ss += sumsq4(v[2 * i]) + sumsq4(v[2 * i + 1]); }
        ss = wave_sum(ss);
        const float r = rsqrtf(ss * (1.0f / D) + EPS);
#pragma unroll
        for (int i = 0; i < 2; ++i) { const f32x4 g0 = *(const f32x4*)(p.final_norm + i * 512 + lane * 8), g1 = *(const f32x4*)(p.final_norm + i * 512 + lane * 8 + 4);
            *(f32x4*)(orow + i * 512 + lane * 8) = v[2 * i] * r * g0; *(f32x4*)(orow + i * 512 + lane * 8 + 4) = v[2 * i + 1] * r * g1; }
    }
}

constexpr int KROW = 400, VROW = 144, KTILE_B = 64 * KROW, VTILE_B = 128 * VROW, ATT_BUF = KTILE_B + VTILE_B;
__device__ __forceinline__ void attn_phase(CParams& p, LAS unsigned char* lds, int wv) {
    const int tid = opaque_tid(wv), wid = __builtin_amdgcn_readfirstlane(tid >> 6), lane_w = tid & 63;
    const bf16_t* qbp = (const bf16_t*)(p.ws + R_QB); bf16_t* ob = (bf16_t*)(p.ws + R_OB);
    for (int item = blockIdx.x; item < 256; item += gridDim.x) {
        const int h = item & 7, pr = item >> 3;
        for (int half = 0; half < 2; ++half) {
            int lane_o = lane_w; asm volatile("" : "+v"(lane_o));
            const int lane = lane_o, j16 = lane & 15, quad = lane >> 4, gsw = ((j16 >> 2) ^ (j16 >> 3)) & 1, kgx = quad ^ gsw;
            const int qblk = half == 0 ? 63 - pr : pr, ntile = 4 * qblk + 4;
            const int q0 = qblk * 256 + wid * 32, last_tile = (q0 + 31) >> 6;
            unsigned goff[6], gstr[6];
#pragma unroll
            for (int j = 0; j < 6; ++j) {
                const int g = (wid + 8 * j) * 64 + lane;
                if (g < 1600) { const int row = g / 25, sc = g % 25, cc = sc < 24 ? (sc ^ (((row >> 2) ^ (row >> 3)) & 1)) : 0;
                    if (cc >= 16) { goff[j] = (unsigned)R_HB + (unsigned)(row * 768 + 640 + (cc - 16) * 8) * 2u; gstr[j] = 64u * 768u * 2u; }
                    else { goff[j] = (unsigned)R_KN + (unsigned)(row * 1024 + h * 128 + cc * 8) * 2u; gstr[j] = 64u * 1024u * 2u; } }
                else { const int g2 = g - 1600, d = g2 / 9, sc = g2 % 9, cc = sc < 8 ? (sc ^ (((d >> 2) ^ (d >> 3)) & 1)) : 0;
                    goff[j] = (unsigned)R_VT + (unsigned)((h * 128 + d) * S + cc * 8) * 2u; gstr[j] = 128u; }
            }
            __builtin_amdgcn_sched_barrier(0);
            bf16x8 qf[2][6];
#pragma unroll
            for (int qb = 0; qb < 2; ++qb)
#pragma unroll
                for (int s = 0; s < 6; ++s) qf[qb][s] = *(const bf16x8*)(qbp + (size_t)(q0 + 16 * qb + j16) * 1536 + h * 192 + 32 * s + 8 * quad);
            { const float* invf = (const float*)(p.ws + WS_INVF);
#pragma unroll
              for (int qb = 0; qb < 2; ++qb) { const int qpos = p.pos[q0 + 16 * qb + j16];
#pragma unroll
                for (int s = 4; s < 6; ++s) {
                  f32x4 v0, v1; for (int i = 0; i < 4; ++i) { v0[i] = bf2f((bf16_t)qf[qb][s][i]); v1[i] = bf2f((bf16_t)qf[qb][s][4 + i]); }
                  rope8(v0, v1, qpos, 16 * (s - 4) + 4 * quad, invf); qf[qb][s] = pack8(v0, v1); __builtin_amdgcn_sched_barrier(0); } } }
            f32x4 o[8][2];
#pragma unroll
            for (int db = 0; db < 8; ++db) { o[db][0] = (f32x4){0.f, 0.f, 0.f, 0.f}; o[db][1] = (f32x4){0.f, 0.f, 0.f, 0.f}; }
            float mrun[2] = {0.f, 0.f}, lrun[2] = {0.f, 0.f};
            f32x4 negm[2] = {(f32x4){0.f, 0.f, 0.f, 0.f}, (f32x4){0.f, 0.f, 0.f, 0.f}};
            const int nld = wid < 3 ? 6 : 5;
#define ATT_ISSUE(slot_) do { _Pragma("unroll") for (int j = 0; j < 6; ++j) if (j < nld) { \
                __builtin_amdgcn_global_load_lds((const unsigned*)(p.ws + goff[j]), (LAS unsigned*)(lds + (slot_) * ATT_BUF + (wid + 8 * j) * 1024), 16, 0, 0); goff[j] += gstr[j]; } } while (0)
            ATT_ISSUE(0);
            if (ntile > 1) ATT_ISSUE(1);
            int slot = 0;
            for (int kt = 0; kt < ntile; ++kt) {
                const int cur = slot * ATT_BUF;
                if (kt + 1 < ntile) { if (wid < 3) asm volatile("s_waitcnt vmcnt(6)" ::: "memory"); else asm volatile("s_waitcnt vmcnt(5)" ::: "memory"); }
                else asm volatile("s_waitcnt vmcnt(0)" ::: "memory");
                __builtin_amdgcn_s_barrier();
                asm volatile("" ::: "memory");
                if (kt + 2 < ntile) { const int s2 = slot == 0 ? 2 : slot - 1; ATT_ISSUE(s2); }
                if (kt <= last_tile) {
                    f32x4 sa[4][2];
                    const LAS unsigned char* kbase = lds + cur + j16 * KROW + 16 * kgx;
#pragma unroll
                    for (int s = 0; s < 6; ++s)
#pragma unroll
                        for (int kb = 0; kb < 4; ++kb) {
                            const bf16x8 kf = *(const LAS bf16x8*)(kbase + kb * 16 * KROW + 64 * s);
                            sa[kb][0] = mfma16(kf, qf[0][s], s == 0 ? negm[0] : sa[kb][0]); sa[kb][1] = mfma16(kf, qf[1][s], s == 0 ? negm[1] : sa[kb][1]);
                        }
                    if (kt * 64 + 63 > q0) {
                        const float NEG = -__builtin_inff();
#pragma unroll
                        for (int qb = 0; qb < 2; ++qb) { const int dq = q0 + 16 * qb + j16 - kt * 64 - 4 * quad;
#pragma unroll
                            for (int kb = 0; kb < 4; ++kb)
#pragma unroll
                                for (int r = 0; r < 4; ++r) if (16 * kb + r > dq) sa[kb][qb][r] = NEG; }
                    }
                    float tmax[2];
#pragma unroll
                    for (int qb = 0; qb < 2; ++qb) { float m = sa[0][qb][0];
#pragma unroll
                        for (int kb = 0; kb < 4; ++kb)
#pragma unroll
                            for (int r = 0; r < 4; ++r) m = fmaxf(m, sa[kb][qb][r]);
                        tmax[qb] = xor16_max(xor32_max(m)); }
                    if (kt == 0 || __builtin_amdgcn_ballot_w64(tmax[0] > 8.0f || tmax[1] > 8.0f) != 0ull) {
#pragma unroll
                        for (int qb = 0; qb < 2; ++qb) { const float d = kt == 0 ? tmax[qb] : fmaxf(tmax[qb], 0.f), alpha = kt == 0 ? 1.0f : __builtin_amdgcn_exp2f(-d); mrun[qb] += d; lrun[qb] *= alpha;
                            negm[qb] = (f32x4){-mrun[qb], -mrun[qb], -mrun[qb], -mrun[qb]};
#pragma unroll
                            for (int kb = 0; kb < 4; ++kb) sa[kb][qb] -= d;
#pragma unroll
                            for (int db = 0; db < 8; ++db) o[db][qb] *= alpha; }
                    }
#pragma unroll
                    for (int qb = 0; qb < 2; ++qb) { float ps = 0.f;
#pragma unroll
                        for (int kb = 0; kb < 4; ++kb)
#pragma unroll
                            for (int r = 0; r < 4; ++r) { const float e = __builtin_amdgcn_exp2f(sa[kb][qb][r]); sa[kb][qb][r] = e; ps += e; }
                        lrun[qb] += ps; }
                    bf16x8 pfr[2][2];
#pragma unroll
                    for (int qb = 0; qb < 2; ++qb) { pfr[qb][0] = pack8(sa[0][qb], sa[1][qb]); pfr[qb][1] = pack8(sa[2][qb], sa[3][qb]); }
                    const LAS unsigned char* vbase = lds + cur + KTILE_B + j16 * VROW + 16 * kgx;
#pragma unroll
                    for (int ks = 0; ks < 2; ++ks)
#pragma unroll
                        for (int db = 0; db < 8; ++db) {
                            const bf16x8 vf = *(const LAS bf16x8*)(vbase + db * 16 * VROW + 64 * ks);
                            o[db][0] = mfma16(vf, pfr[0][ks], o[db][0]); o[db][1] = mfma16(vf, pfr[1][ks], o[db][1]);
                        }
                }
                slot = slot == 2 ? 0 : slot + 1;
            }
#undef ATT_ISSUE
            asm volatile("s_waitcnt lgkmcnt(0)" ::: "memory");
            __builtin_amdgcn_s_barrier();
            asm volatile("" ::: "memory");
#pragma unroll
            for (int qb = 0; qb < 2; ++qb) {
                const float l = xor16_sum(xor32_sum(lrun[qb])), inv = 1.0f / l;
                bf16_t* orow = ob + (size_t)(q0 + 16 * qb + j16) * 1024 + h * 128 + 4 * quad;
#pragma unroll
                for (int db = 0; db < 8; ++db) { u32x2 w; w.x = cvt_pk_bf16(o[db][qb][0] * inv, o[db][qb][1] * inv); w.y = cvt_pk_bf16(o[db][qb][2] * inv, o[db][qb][3] * inv); *(u32x2*)(orow + 16 * db) = w; }
            }
        }
    }
}

constexpr int TROW = 72;
__device__ __forceinline__ void stage_vT(LAS bf16_t* vTl, const bf16_t* hg, int c, int h, int wv) {
    const int tid = opaque_tid(wv);
#pragma unroll
    for (int j = 0; j < 4; ++j) { const int ch = tid + 512 * j, t = ch >> 5, e8 = (ch & 31) * 8;
        const bf16x8 v = *(const bf16x8*)(hg + (size_t)(64 * c + t) * 3072 + 1024 + 256 * h + e8);
#pragma unroll
        for (int i = 0; i < 8; ++i) vTl[(e8 + i) * TROW + (t ^ (((e8 >> 3) & 7) << 3))] = (bf16_t)v[i]; }
}
__device__ __forceinline__ void gla_gate_proj(CParams& p, LAS unsigned char* lds, int wv) {
    const int tid = opaque_tid(wv), wid = __builtin_amdgcn_readfirstlane(tid >> 6), lane = tid & 63, c = lane & 31, hi = lane >> 5;
    const bf16_t* xbp = (const bf16_t*)(p.ws + WS_XB); const bf16_t* wa = (const bf16_t*)(p.ws + WS_WMIX) + (size_t)3072 * 1024;
    const float* ssq = (const float*)(p.ws + WS_SSQX); float* ab = (float*)(p.ws + R_AB);
    LAS float* part = (LAS float*)lds;
    for (int blk = blockIdx.x; blk < S / 64; blk += gridDim.x) {
        const int r0 = blk * 64;
        f32x16 acc0 = zero16(), acc1 = zero16();
#pragma unroll
        for (int s = 0; s < 8; ++s) {
            const int ko = 16 * (wid * 8 + s) + 8 * hi;
            const bf16x8 b = *(const bf16x8*)(wa + (size_t)(c & 15) * 1024 + ko);
            const bf16x8 a0 = *(const bf16x8*)(xbp + (size_t)(r0 + c) * 1024 + ko), a1 = *(const bf16x8*)(xbp + (size_t)(r0 + 32 + c) * 1024 + ko);
            acc0 = mfma32(a0, b, acc0); acc1 = mfma32(a1, b, acc1);
        }
        if (c < 16) {
#pragma unroll
            for (int r = 0; r < 16; ++r) { part[(wid * 64 + crow(r, hi)) * 16 + c] = acc0[r]; part[(wid * 64 + 32 + crow(r, hi)) * 16 + c] = acc1[r]; }
        }
        __syncthreads();
#pragma unroll
        for (int jj = 0; jj < 2; ++jj) {
            const int idx = tid + 512 * jj, row = idx >> 4, col = idx & 15; float s = 0.f;
#pragma unroll
            for (int w8 = 0; w8 < 8; ++w8) s += part[(w8 * 64 + row) * 16 + col];
            float q = 0.f;
#pragma unroll
            for (int i = 0; i < 4; ++i) { const f32x4 v = *(const f32x4*)(ssq + (size_t)(r0 + row) * 16 + 4 * i); q += (v[0] + v[1]) + (v[2] + v[3]); }
            ab[(size_t)(r0 + row) * 16 + col] = s * rsqrtf(q * (1.0f / 1024.0f) + EPS);
        }
        __syncthreads();
    }
}
__device__ __forceinline__ void gla_passA(CParams& p, LAS unsigned char* lds, int j, int wv) {
    const int tid = opaque_tid(wv), wid = __builtin_amdgcn_readfirstlane(tid >> 6), lane = tid & 63, c = lane & 31, hi = lane >> 5;
    LAS bf16_t* kTl = (LAS bf16_t*)lds; LAS bf16_t* vTl = (LAS bf16_t*)(lds + 128 * TROW * 2); LAS float* tot = (LAS float*)(lds + (128 + 256) * TROW * 2);
    bf16_t* hg = (bf16_t*)(p.ws + R_HG); const float* ab = (const float*)(p.ws + R_AB); bf16_t* U = (bf16_t*)(p.ws + R_U); float* dec = (float*)(p.ws + R_DEC);
    const float* Wg = p.gla_w_gk_up + (size_t)j * 16 * 512; const float* bg = p.gla_b_gk + j * 512;
    for (int item = blockIdx.x; item < 1024; item += gridDim.x) {
        const int ch = item >> 2, h = item & 3, d = tid & 127, tg = tid >> 7;
        float w[16];
#pragma unroll
        for (int r = 0; r < 16; ++r) w[r] = Wg[r * 512 + 128 * h + d];
        const float bias = bg[128 * h + d];
        float cum[16]; float run = 0.f;
        const size_t ro0 = (size_t)(64 * ch + 16 * tg) * 3072 + 128 * h + d;
        bf16_t qraw[16], kraw[16];
#pragma unroll
        for (int tt = 0; tt < 16; ++tt) { qraw[tt] = hg[ro0 + (size_t)tt * 3072]; kraw[tt] = hg[ro0 + (size_t)tt * 3072 + 512]; }
#pragma unroll
        for (int tt = 0; tt < 16; ++tt) {
            const float* ar = ab + (size_t)(64 * ch + 16 * tg + tt) * 16; float z = bias;
#pragma unroll
            for (int r4 = 0; r4 < 4; ++r4) { const f32x4 a = *(const f32x4*)(ar + 4 * r4); z += a[0] * w[4 * r4] + a[1] * w[4 * r4 + 1] + a[2] * w[4 * r4 + 2] + a[3] * w[4 * r4 + 3]; }
            const float ls = fminf(z, 0.f) - __logf(1.0f + __expf(-fabsf(z)));
            run += ls * 0.0625f; cum[tt] = run;
        }
        tot[tg * 128 + d] = run;
        __syncthreads();
        float off = 0.f, total = 0.f;
#pragma unroll
        for (int g = 0; g < 4; ++g) { const float t_ = tot[g * 128 + d]; total += t_; if (g < tg) off += t_; }
#pragma unroll
        for (int tt = 0; tt < 16; ++tt) {
            const float b = cum[tt] + off; const size_t ro = ro0 + (size_t)tt * 3072;
            const float qv = bf2f(qraw[tt]), kv = bf2f(kraw[tt]);
            const float eb = __expf(b), enb = __expf(-b);
            hg[ro] = f2bf(qv * 0.08838834764831845f * eb);
            hg[ro + 512] = f2bf(kv * enb);
            kTl[d * TROW + 16 * tg + tt] = f2bf(kv * __expf(total - b));
        }
        if (tg == 0) dec[(size_t)item * 128 + d] = __expf(total);
        stage_vT(vTl, hg, ch, h, wv);
        __syncthreads();
        f32x16 acc[4]; for (int i = 0; i < 4; ++i) acc[i] = zero16();
#pragma unroll
        for (int s = 0; s < 4; ++s) {
            const bf16x8 bf = *(const LAS bf16x8*)(vTl + (32 * wid + c) * TROW + (((2 * s + hi) ^ (((32 * wid + c) >> 3) & 7)) << 3));
#pragma unroll
            for (int db = 0; db < 4; ++db) { const bf16x8 af = *(const LAS bf16x8*)(kTl + (32 * db + c) * TROW + 16 * s + 8 * hi); acc[db] = mfma32(af, bf, acc[db]); }
        }
        bf16_t* up = U + ((size_t)item * 256 + 32 * wid + c) * 128;
#pragma unroll
        for (int db = 0; db < 4; ++db)
#pragma unroll
            for (int g = 0; g < 4; ++g) { u32x2 wv; wv.x = cvt_pk_bf16(acc[db][4 * g], acc[db][4 * g + 1]); wv.y = cvt_pk_bf16(acc[db][4 * g + 2], acc[db][4 * g + 3]); *(u32x2*)(up + 32 * db + 8 * g + 4 * hi) = wv; }
        __syncthreads();
    }
}
__device__ __forceinline__ void gla_scan(CParams& p, int wv) {
    bf16_t* U = (bf16_t*)(p.ws + R_U); const float* dec = (const float*)(p.ws + R_DEC);
    const int tid = opaque_tid(wv);
    for (int idx = blockIdx.x * NTHR + tid; idx < 4 * 256 * 128; idx += gridDim.x * NTHR) {
        const int h = idx >> 15, rem = idx & 32767, d = rem & 127;
        bf16_t* up = U + (size_t)h * 32768 + rem; const float* dp = dec + h * 128 + d; float st = 0.f;
        float u[32], dc[32], un[32], dn[32];
#pragma unroll
        for (int i = 0; i < 32; ++i) { u[i] = bf2f(up[(size_t)i * 131072]); dc[i] = dp[(size_t)i * 512]; }
        for (int c0 = 0; c0 < 256; c0 += 32) {
            if (c0 + 32 < 256) {
#pragma unroll
                for (int i = 0; i < 32; ++i) { un[i] = bf2f(up[(size_t)(c0 + 32 + i) * 131072]); dn[i] = dp[(size_t)(c0 + 32 + i) * 512]; }
            }
#pragma unroll
            for (int i = 0; i < 32; ++i) { up[(size_t)(c0 + i) * 131072] = f2bf(st); st = st * dc[i] + u[i]; }
#pragma unroll
            for (int i = 0; i < 32; ++i) { u[i] = un[i]; dc[i] = dn[i]; }
        }
    }
}
__device__ __forceinline__ void gla_passC(CParams& p, LAS unsigned char* lds, int j, int wv) {
    const int tid = opaque_tid(wv), wid = __builtin_amdgcn_readfirstlane(tid >> 6), lane = tid & 63, c = lane & 31, hi = lane >> 5;
    LAS bf16_t* vTl = (LAS bf16_t*)lds; LAS bf16_t* at = (LAS bf16_t*)(lds + 256 * TROW * 2); LAS float* red = (LAS float*)(lds + (256 + 64) * TROW * 2);
    const bf16_t* hg = (const bf16_t*)(p.ws + R_HG); const bf16_t* Sb = (const bf16_t*)(p.ws + R_U); bf16_t* y = (bf16_t*)(p.ws + R_Y);
    const float* gn = p.gla_g_norm + j * 256;
    for (int item = blockIdx.x; item < 1024; item += gridDim.x) {
        const int ch = item >> 2, h = item & 3;
        stage_vT(vTl, hg, ch, h, wv);
        if (wid < 3) {
            const int tb = wid == 0 ? 0 : 1, sb = wid == 2 ? 1 : 0; f32x16 a = zero16();
#pragma unroll
            for (int s = 0; s < 8; ++s) {
                const bf16x8 qf = *(const bf16x8*)(hg + (size_t)(64 * ch + 32 * tb + c) * 3072 + 128 * h + 16 * s + 8 * hi);
                const bf16x8 kf = *(const bf16x8*)(hg + (size_t)(64 * ch + 32 * sb + c) * 3072 + 512 + 128 * h + 16 * s + 8 * hi);
                a = mfma32(qf, kf, a);
            }
#pragma unroll
            for (int r = 0; r < 16; ++r) { const int t = crow(r, hi); float v = a[r]; if (tb == sb && c > t) v = 0.f; at[(32 * tb + t) * TROW + 32 * sb + c] = f2bf(v); }
        } else if (wid == 3) {
#pragma unroll
            for (int r = 0; r < 16; ++r) at[crow(r, hi) * TROW + 32 + c] = 0;
        }
        __syncthreads();
        f32x16 o[2]; o[0] = zero16(); o[1] = zero16();
        const bf16_t* sp = Sb + ((size_t)item * 256 + 32 * wid + c) * 128 + 8 * hi;
#pragma unroll
        for (int s = 0; s < 8; ++s) {
            const bf16x8 sf = *(const bf16x8*)(sp + 16 * s);
#pragma unroll
            for (int tb = 0; tb < 2; ++tb) { const bf16x8 qf = *(const bf16x8*)(hg + (size_t)(64 * ch + 32 * tb + c) * 3072 + 128 * h + 16 * s + 8 * hi); o[tb] = mfma32(sf, qf, o[tb]); }
        }
#pragma unroll
        for (int s = 0; s < 4; ++s) {
            const bf16x8 vf = *(const LAS bf16x8*)(vTl + (32 * wid + c) * TROW + (((2 * s + hi) ^ (((32 * wid + c) >> 3) & 7)) << 3));
#pragma unroll
            for (int tb = 0; tb < 2; ++tb) { const bf16x8 af = *(const LAS bf16x8*)(at + (32 * tb + c) * TROW + 16 * s + 8 * hi); o[tb] = mfma32(vf, af, o[tb]); }
        }
#pragma unroll
        for (int tb = 0; tb < 2; ++tb) { float ss = 0.f;
#pragma unroll
            for (int r = 0; r < 16; ++r) ss += o[tb][r] * o[tb][r];
            ss = xor32_sum(ss); if (hi == 0) red[wid * 64 + 32 * tb + c] = ss; }
        __syncthreads();
#pragma unroll
        for (int tb = 0; tb < 2; ++tb) {
            float tot = 0.f;
#pragma unroll
            for (int w8 = 0; w8 < 8; ++w8) tot += red[w8 * 64 + 32 * tb + c];
            const float rstd = rsqrtf(tot * (1.0f / 256.0f) + EPS); const size_t tok = (size_t)(64 * ch + 32 * tb + c);
#pragma unroll
            for (int g = 0; g < 4; ++g) {
                const int e0 = 32 * wid + 8 * g + 4 * hi;
                const s16x4 gv = *(const s16x4*)(hg + tok * 3072 + 2048 + 256 * h + e0); const f32x4 gg = *(const f32x4*)(gn + e0);
                float r4[4];
#pragma unroll
                for (int i = 0; i < 4; ++i) { const float gx = bf2f((bf16_t)gv[i]); const float sl = gx / (1.0f + expf(-gx)); r4[i] = o[tb][4 * g + i] * rstd * gg[i] * sl; }
                u32x2 wv; wv.x = cvt_pk_bf16(r4[0], r4[1]); wv.y = cvt_pk_bf16(r4[2], r4[3]); *(u32x2*)(y + tok * 1024 + 256 * h + e0) = wv;
            }
        }
        __syncthreads();
    }
}

#define XB_TMO      128
#define XB_XCNT(j)  (256  + 64 * (j))
#define XB_XSUB(j)  (1280 + 64 * (j))
#define XB_XGEN(j)  (2304 + 64 * (j))
#define XB_TOP      3328
#define XB_TOPGEN   3392
#define XCD_BAR_WORDS 3456
#define XB_SPIN_CAP (1u << 18)
__device__ __forceinline__ unsigned xb_ld(unsigned* p)              { return __hip_atomic_load(p, __ATOMIC_RELAXED, __HIP_MEMORY_SCOPE_AGENT); }
__device__ __forceinline__ unsigned xb_add(unsigned* p, unsigned v) { return __hip_atomic_fetch_add(p, v, __ATOMIC_RELAXED, __HIP_MEMORY_SCOPE_AGENT); }
__device__ __forceinline__ unsigned xb_xcc_id() { return (unsigned)__builtin_amdgcn_s_getreg((3 << 11) | 20) & 0xFu; }
#define XB_SPIN(cond, bar) do { unsigned _sp = 0; while (cond) { __builtin_amdgcn_s_sleep(1); \
    if ((++_sp & 255u) == 0u) { if (xb_ld(&(bar)[XB_TMO])) break; if (_sp > XB_SPIN_CAP) { atomicAdd(&(bar)[XB_TMO], 1u); break; } } } } while (0)
__device__ __forceinline__ void xcd_barrier_complete(unsigned* bar, unsigned x, unsigned& nloc, unsigned& nx) {
    const unsigned G = gridDim.x;
    unsigned sum, cnt, mine, sp = 0u;
    for (;;) {
        sum = 0u; cnt = 0u; mine = 0u;
#pragma unroll
        for (unsigned j = 0; j < 16; ++j) { const unsigned c = xb_ld(&bar[XB_XCNT(j)]); sum += c; cnt += (c > 0u) ? 1u : 0u; mine = (j == x) ? c : mine; }
        if (sum == G) break;
        __builtin_amdgcn_s_sleep(1);
        if ((++sp & 255u) == 0u) { if (xb_ld(&bar[XB_TMO])) break; if (sp > XB_SPIN_CAP) { atomicAdd(&bar[XB_TMO], 1u); break; } }
    }
    nloc = mine > 0u ? mine : 1u; nx = cnt > 0u ? cnt : 1u;
}
__device__ __forceinline__ void xcd_barrier(unsigned* bar, unsigned x, volatile LAS unsigned* st, int wv) {
    const int tid = opaque_tid(wv);
    asm volatile("s_waitcnt vmcnt(0)" ::: "memory");
    __syncthreads();
    if (tid == 0) {
        __builtin_amdgcn_s_waitcnt(0);
        unsigned nloc = st[0], nx = st[1];
        if (nloc == 0u) { xcd_barrier_complete(bar, x, nloc, nx); st[0] = nloc; st[1] = nx; }
        const unsigned old = xb_add(&bar[XB_XSUB(x)], 1u);
        const unsigned gen = old / nloc;
        if (old + 1u == (gen + 1u) * nloc) {
            __builtin_amdgcn_fence(__ATOMIC_RELEASE, "agent");
            asm volatile("s_waitcnt vmcnt(0)" ::: "memory");
            const unsigned og = xb_add(&bar[XB_TOP], 1u);
            const unsigned tg = og / nx;
            if (og + 1u == (tg + 1u) * nx) xb_add(&bar[XB_TOPGEN], 1u);
            else XB_SPIN(xb_ld(&bar[XB_TOPGEN]) == tg, bar);
            __builtin_amdgcn_fence(__ATOMIC_ACQUIRE, "agent");
            xb_add(&bar[XB_XGEN(x)], 1u);
            asm volatile("s_waitcnt vmcnt(0)" ::: "memory");
        } else {
            XB_SPIN(xb_ld(&bar[XB_XGEN(x)]) == gen, bar);
            __builtin_amdgcn_fence(__ATOMIC_ACQUIRE, "agent");
            asm volatile("s_waitcnt vmcnt(0)" ::: "memory");
        }
    }
    __syncthreads();
}
__global__ void __launch_bounds__(512) mk_fwd(Params p0) {
    extern __shared__ __attribute__((aligned(16))) unsigned char shm[];
    LAS unsigned char* lds = (LAS unsigned char*)shm;
    cg::grid_group grid = cg::this_grid();
    int ph = 0;
    const int wv = __builtin_amdgcn_readfirstlane((int)(threadIdx.x >> 6));
    if (p0.ph_lo < 0) grid.sync();
    volatile LAS unsigned* xst = (volatile LAS unsigned*)(lds + 132096);
    const unsigned xcc = xb_xcc_id();
    if (p0.ph_hi - p0.ph_lo > 1) {
        if (threadIdx.x == 0) { xst[0] = 0u; xst[1] = 0u; xb_add(&((unsigned*)(p0.ws + WS_BAR))[XB_XCNT(xcc)], 1u); }
        __syncthreads();
    }
    const int ph_lo = p0.ph_lo, ph_hi = p0.ph_hi;
#define hb ((bf16_t*)(p.ws + R_HB))
#define ssqkv ((float*)(p.ws + R_SSQKV))
#define ssqq ((float*)(p.ws + R_SSQQ))
#define qb ((bf16_t*)(p.ws + R_QB))
#define kn ((bf16_t*)(p.ws + R_KN))
#define vT ((bf16_t*)(p.ws + R_VT))
#define hg ((bf16_t*)(p.ws + R_HG))
#define ab ((float*)(p.ws + R_AB))
#define PHASE_BEGIN if (ph >= ph_lo && ph < ph_hi) { CParams* kp_ = (CParams*)__builtin_amdgcn_kernarg_segment_ptr(); asm volatile("" : "+s"(kp_)); CParams& p = *kp_;
#define PHASE_END   if (ph + 1 < ph_hi) xcd_barrier((unsigned*)(p.ws + WS_BAR), xcc, xst, wv); } ++ph;
#define xb ((bf16_t*)(p.ws + WS_XB))
#define ssqx ((float*)(p.ws + WS_SSQX))
#define invf ((const float*)(p.ws + WS_INVF))
#define wm ((bf16_t*)(p.ws + WS_WMIX))
#define wl ((bf16_t*)(p.ws + WS_WMLP))
    PHASE_BEGIN
        prologue_x(p, wv); conv_mixer(p, lds, 0, wv);
    PHASE_END
    auto layer_body = [&](auto LC) __attribute__((always_inline)) {
        constexpr int layer = decltype(LC)::value;
        constexpr int j = layer >> 1;
        if ((layer & 1) == 0) {
            PHASE_BEGIN
                EpiRow<M_MLAIN> E{hb, 768, ssqx, 4, 1.0f / 1024.0f, ssqkv, ssqq, nullptr, p.pos, invf};
                run_gemm(lds, xb, 1024, wm + WM_IN, 1024, S, 768, 1024, E, 0, wv);
                conv_mlp_weighted(p, lds, layer, wv, 192);
            PHASE_END
            PHASE_BEGIN
                { EpiRow<M_PLAIN> E{qb, 1536, ssqq, 2, 1.0f / 384.0f, nullptr, nullptr, nullptr, p.pos, invf};
                  run_gemm(lds, hb + 256, 768, wm + WM_UQ, 384, S, 1536, 384, E, 0, wv); }
                { EpiRow<M_PLAIN> E{kn, 1024, ssqkv, 1, 1.0f / 256.0f, nullptr, nullptr, nullptr, nullptr, nullptr};
                  run_gemm(lds, hb, 768, wm + WM_UK, 256, S, 1024, 256, E, 128, wv); }
                { EpiVT E{vT, ssqkv, 1.0f / 256.0f};
                  run_gemm(lds, wm + WM_UV, 256, hb, 768, 1024, S, 256, E, 128, wv); }
            PHASE_END
            PHASE_BEGIN
                attn_phase(p, lds, wv);
            PHASE_END
        } else {
            PHASE_BEGIN
                EpiRow<M_GLAIN> E{hg, 3072, ssqx, 4, 1.0f / 1024.0f, nullptr, nullptr, ab, nullptr, nullptr};
                run_gemm(lds, xb, 1024, wm + WM_IN, 1024, S, 3072, 1024, E, 0, wv);
                gla_gate_proj(p, lds, wv);
                conv_mlp(p, lds, layer, wv);
            PHASE_END
            PHASE_BEGIN
                gla_passA(p, lds, j, wv);
            PHASE_END
            PHASE_BEGIN
                gla_scan(p, wv);
            PHASE_END
            PHASE_BEGIN
                gla_passC(p, lds, j, wv);
            PHASE_END
        }
        PHASE_BEGIN
            const bool mla = (layer & 1) == 0;
            EpiRes E{xb, ssqx};
            run_gemm(lds, (const bf16_t*)(p.ws + (mla ? R_OB : R_Y)), 1024, wm + (mla ? WM_O_MLA : WM_O_GLA), 1024, S, 1024, 1024, E, 0, wv);
        PHASE_END
        PHASE_BEGIN
            EpiRow<M_SQRELU> E{(bf16_t*)(p.ws + R_HID), 4096, ssqx, 4, 1.0f / 1024.0f, nullptr, nullptr, nullptr, nullptr, nullptr};
            run_gemm(lds, xb, 1024, wl, 1024, S, 4096, 1024, E, 0, wv);
            if (layer < 3) conv_mixer(p, lds, layer + 1, wv);
        PHASE_END
        PHASE_BEGIN
            EpiRes E{xb, ssqx};
            run_gemm(lds, (const bf16_t*)(p.ws + R_HID), 4096, wl + (size_t)DFF * D, 4096, S, 1024, 4096, E, 0, wv);
        PHASE_END
    };
    layer_body(std::integral_constant<int, 0>{}); layer_body(std::integral_constant<int, 1>{}); layer_body(std::integral_constant<int, 2>{}); layer_body(std::integral_constant<int, 3>{});
    PHASE_BEGIN
        final_norm(p, wv);
    PHASE_END
}
#undef xb
#undef ssqx
#undef invf
#undef wm
#undef wl
#undef hb
#undef ssqkv
#undef ssqq
#undef qb
#undef kn
#undef vT
#undef hg
#undef ab
constexpr int N_PHASES = 1 + 2 * (4 + 2) + 2 * (5 + 2) + 1;

extern "C" void kernel_launch(void* const* d_in, const int* in_sizes, int n_in, void* d_out, int out_size, void* d_ws, size_t ws_size, hipStream_t stream) {
    static int grid = 0;
    if (grid == 0) {
        if (n_in != 18 || out_size != S * D || ws_size < WS_END) { fprintf(stderr, "kernel_launch: unexpected shapes (n_in %d out %d ws %zu need %zu)\n", n_in, out_size, ws_size, (size_t)WS_END); grid = -1; return; }
        int dev = 0, cus = 0, per_cu = 0;
        hipGetDevice(&dev); hipDeviceGetAttribute(&cus, hipDeviceAttributeMultiprocessorCount, dev);
        if (hipFuncSetAttribute((const void*)mk_fwd, hipFuncAttributeMaxDynamicSharedMemorySize, LDS_BYTES) != hipSuccess) { fprintf(stderr, "kernel_launch: hipFuncSetAttribute failed\n"); grid = -1; return; }
        if (hipOccupancyMaxActiveBlocksPerMultiprocessor(&per_cu, (const void*)mk_fwd, NTHR, LDS_BYTES) != hipSuccess || per_cu < 1) { fprintf(stderr, "kernel_launch: occupancy query gave %d\n", per_cu); per_cu = 1; }
        (void)hipGetLastError();
        grid = cus * per_cu;
        fprintf(stderr, "kernel_launch: grid %d (cus %d x %d)\n", grid, cus, per_cu);
    }
    if (grid < 0) return;
    Params p{};
    p.x = (const float*)d_in[0]; p.pos = (const int*)d_in[1]; p.norm_mix = (const float*)d_in[2]; p.norm_mlp = (const float*)d_in[3];
    p.mla_w_in = (const float*)d_in[4]; p.mla_q_norm = (const float*)d_in[5]; p.mla_w_uq = (const float*)d_in[6]; p.mla_kv_norm = (const float*)d_in[7];
    p.mla_w_ukv = (const float*)d_in[8]; p.mla_w_o = (const float*)d_in[9];
    p.gla_w_in = (const float*)d_in[10]; p.gla_w_gk_up = (const float*)d_in[11]; p.gla_b_gk = (const float*)d_in[12]; p.gla_g_norm = (const float*)d_in[13]; p.gla_w_o = (const float*)d_in[14];
    p.mlp_w_up = (const float*)d_in[15]; p.mlp_w_down = (const float*)d_in[16]; p.final_norm = (const float*)d_in[17];
    p.out = (float*)d_out; p.ws = (unsigned char*)d_ws;
#if N_LAUNCH_MODE == 1
    p.ph_lo = 0; p.ph_hi = N_PHASES;
    if (hipMemsetAsync((char*)d_ws + WS_BAR, 0, XCD_BAR_WORDS * 4, stream) != hipSuccess) { fprintf(stderr, "kernel_launch: memset of barrier words failed\n"); return; }
    void* args[] = {&p};
    hipError_t e = hipLaunchCooperativeKernel((const void*)mk_fwd, dim3(grid), dim3(NTHR), args, LDS_BYTES, stream);
    if (e != hipSuccess) fprintf(stderr, "cooperative launch failed: %s (grid %d)\n", hipGetErrorString(e), grid);
#else
    for (int ph = 0; ph < N_PHASES; ++ph) { p.ph_lo = ph; p.ph_hi = ph + 1; hipLaunchKernelGGL(mk_fwd, dim3(grid), dim3(NTHR), LDS_BYTES, stream, p); }
#endif
}
```

```cpp
#include <hip/hip_runtime.h>
#include <hip/hip_cooperative_groups.h>
#include <cstdio>
#include <type_traits>
namespace cg = cooperative_groups;

#define LAS __attribute__((address_space(3)))
typedef unsigned short bf16_t;
typedef short bf16x8 __attribute__((ext_vector_type(8)));
typedef short s16x4 __attribute__((ext_vector_type(4)));
typedef float f32x4 __attribute__((ext_vector_type(4)));
typedef float f32x16 __attribute__((ext_vector_type(16)));
typedef unsigned u32x4 __attribute__((ext_vector_type(4)));
typedef unsigned u32x2 __attribute__((ext_vector_type(2)));

#ifndef N_LAUNCH_MODE
#define N_LAUNCH_MODE 1
#endif

constexpr int S = 16384, D = 1024, DFF = 4096, NTHR = 512;
constexpr float EPS = 1e-6f;
constexpr int LDS_BYTES = 132096 + 1024;

constexpr size_t WS_XB = 0;
constexpr size_t WS_SSQX = WS_XB + (size_t)S * D * 2;
constexpr size_t WS_INVF = WS_SSQX + (size_t)S * 16 * 4;
constexpr size_t WS_BAR = WS_INVF + 1024;
constexpr size_t WS_WMIX = WS_BAR + 16384;
constexpr size_t WMIX_BYTES = (size_t)(3328 + 1024) * 1024 * 2;
constexpr size_t WS_WMLP = WS_WMIX + WMIX_BYTES;
constexpr size_t WS_R = WS_WMLP + (size_t)2 * DFF * D * 2;
constexpr size_t R_HB = WS_R;
constexpr size_t R_SSQKV = R_HB + (size_t)S * 768 * 2;
constexpr size_t R_SSQQ = R_SSQKV + (size_t)S * 16 * 4;
constexpr size_t R_QB = R_SSQQ + (size_t)S * 16 * 4;
constexpr size_t R_KN = R_QB + (size_t)S * 1536 * 2;
constexpr size_t R_VT = R_KN + (size_t)S * 1024 * 2;
constexpr size_t R_OB = R_VT + (size_t)S * 1024 * 2;
constexpr size_t R_MLA_END = R_OB + (size_t)S * 1024 * 2;
constexpr size_t R_HG = WS_R;
constexpr size_t R_AB = R_HG + (size_t)S * 3072 * 2;
constexpr size_t R_U = R_AB + (size_t)S * 16 * 4;
constexpr size_t R_DEC = R_U + (size_t)256 * 4 * 256 * 128 * 2;
constexpr size_t R_Y = R_DEC + (size_t)256 * 4 * 128 * 4;
constexpr size_t R_GLA_END = R_Y + (size_t)S * 1024 * 2;
constexpr size_t R_HID = WS_R;
constexpr size_t R_MLP_END = R_HID + (size_t)S * DFF * 2;
constexpr size_t WS_END = R_GLA_END > R_MLA_END ? (R_GLA_END > R_MLP_END ? R_GLA_END : R_MLP_END) : (R_MLA_END > R_MLP_END ? R_MLA_END : R_MLP_END);
constexpr size_t WM_IN = 0;
constexpr size_t WM_UQ = WM_IN + (size_t)768 * 1024;
constexpr size_t WM_UK = WM_UQ + (size_t)1536 * 384;
constexpr size_t WM_UV = WM_UK + (size_t)1024 * 256;
constexpr size_t WM_O_MLA = WM_UV + (size_t)1024 * 256;
constexpr size_t WM_O_GLA = (size_t)3328 * 1024;

struct Params {
    const float* x; const int* pos; const float* norm_mix; const float* norm_mlp;
    const float* mla_w_in; const float* mla_q_norm; const float* mla_w_uq; const float* mla_kv_norm; const float* mla_w_ukv; const float* mla_w_o;
    const float* gla_w_in; const float* gla_w_gk_up; const float* gla_b_gk; const float* gla_g_norm; const float* gla_w_o;
    const float* mlp_w_up; const float* mlp_w_down; const float* final_norm;
    float* out; unsigned char* ws;
    int ph_lo, ph_hi;
};

typedef const __attribute__((address_space(4))) Params CParams;
__device__ __forceinline__ bf16_t f2bf(float f) { unsigned u = __float_as_uint(f); u += 0x7FFFu + ((u >> 16) & 1u); return (bf16_t)(u >> 16); }
__device__ __forceinline__ float bf2f(bf16_t b) { return __uint_as_float(((unsigned)b) << 16); }
typedef __bf16 bf16v2_t __attribute__((ext_vector_type(2)));
__device__ __forceinline__ unsigned cvt_pk_bf16(float lo, float hi) { bf16v2_t v = {(__bf16)lo, (__bf16)hi}; return __builtin_bit_cast(unsigned, v); }
__device__ __forceinline__ bf16x8 pack8(f32x4 a, f32x4 b) { u32x4 w = {cvt_pk_bf16(a[0], a[1]), cvt_pk_bf16(a[2], a[3]), cvt_pk_bf16(b[0], b[1]), cvt_pk_bf16(b[2], b[3])}; return *reinterpret_cast<bf16x8*>(&w); }
__device__ __forceinline__ f32x16 mfma32(bf16x8 a, bf16x8 b, f32x16 c) { return __builtin_amdgcn_mfma_f32_32x32x16_bf16(a, b, c, 0, 0, 0); }
__device__ __forceinline__ int crow(int r, int hi) { return (r & 3) + 8 * (r >> 2) + 4 * hi; }
__device__ __forceinline__ f32x16 zero16() { f32x16 z; for (int i = 0; i < 16; ++i) z[i] = 0.f; return z; }
__device__ __forceinline__ int opaque_tid(int wv) { int l; asm volatile("v_mbcnt_lo_u32_b32 %0, -1, 0\n\tv_mbcnt_hi_u32_b32 %0, -1, %0" : "=v"(l)); return wv * 64 + l; }
__device__ __forceinline__ float xor16_sum(float x) { auto r = __builtin_amdgcn_permlane16_swap(__float_as_uint(x), __float_as_uint(x), false, false); return __uint_as_float(r[0]) + __uint_as_float(r[1]); }
__device__ __forceinline__ float xor32_sum(float x) { auto r = __builtin_amdgcn_permlane32_swap(__float_as_uint(x), __float_as_uint(x), false, false); return __uint_as_float(r[0]) + __uint_as_float(r[1]); }
__device__ __forceinline__ float xor32_max(float x) { auto r = __builtin_amdgcn_permlane32_swap(__float_as_uint(x), __float_as_uint(x), false, false); return fmaxf(__uint_as_float(r[0]), __uint_as_float(r[1])); }
__device__ __forceinline__ float xor16_max(float x) { auto r = __builtin_amdgcn_permlane16_swap(__float_as_uint(x), __float_as_uint(x), false, false); return fmaxf(__uint_as_float(r[0]), __uint_as_float(r[1])); }
__device__ __forceinline__ f32x4 mfma16(bf16x8 a, bf16x8 b, f32x4 c) { return __builtin_amdgcn_mfma_f32_16x16x32_bf16(a, b, c, 0, 0, 0); }
__device__ __forceinline__ float wave_sum(float x) {
    x = xor32_sum(x); x = xor16_sum(x);
    x += __uint_as_float(__builtin_amdgcn_ds_swizzle(__float_as_uint(x), 0x201F)); x += __uint_as_float(__builtin_amdgcn_ds_swizzle(__float_as_uint(x), 0x101F));
    x += __uint_as_float(__builtin_amdgcn_ds_swizzle(__float_as_uint(x), 0x081F)); x += __uint_as_float(__builtin_amdgcn_ds_swizzle(__float_as_uint(x), 0x041F));
    return x;
}
__device__ __forceinline__ void sincos_acc(float ang, float& sn, float& cs) {
    const double a = (double)ang * 0.63661977236758134308; const double q = __builtin_rint(a);
    const float x = (float)((a - q) * 1.57079632679489661923); const int qi = (int)q; const float x2 = x * x;
    const float s = x + x * x2 * (-1.6666654611e-1f + x2 * (8.3321608736e-3f + x2 * (-1.9515295891e-4f)));
    const float c = 1.0f - 0.5f * x2 + x2 * x2 * (4.166664568298827e-2f + x2 * (-1.388731625493765e-3f + x2 * 2.443315711809948e-5f));
    const int k = qi & 3;
    sn = (k == 0) ? s : (k == 1) ? c : (k == 2) ? -s : -c;
    cs = (k == 0) ? c : (k == 1) ? -s : (k == 2) ? -c : s;
}

namespace pg8 {
constexpr int BM = 256, BK = 64, HALF = 128, HTB = HALF * BK * 2, STAGE_BYTES = 8 * HTB, NXCD = 8, WGM = 8;
__device__ __forceinline__ int lds_byte(int r, int c) { const int st = (r >> 4) * 2 + (c >> 5), rr = r & 15, cc = c & 31, ob = rr * 64 + cc * 2; return st * 1024 + (ob ^ (((ob >> 9) & 1) << 5)); }
__device__ __forceinline__ void stage_rc(int b, int& R, int& C) { const int st = b / 1024, sb = b % 1024, swz = sb ^ (((sb >> 9) & 1) << 5); R = (st >> 1) * 16 + swz / 64; C = (st & 1) * 32 + (swz % 64) / 2; }
__device__ __forceinline__ int perm32(int rho) { const int n = rho >> 4, i = rho & 15; return 8 * (i >> 2) + 4 * n + (i & 3); }
struct Unit { int pm, pn; };
struct Gemm { const bf16_t* A; const bf16_t* Bt; int M, N, K, lda, ldb; };
struct StaticOrder {
    int nM, nN, nwg, G, c;
    __device__ void init(int M, int N, int G_, int c_) { nM = M / BM; nN = N / BM; nwg = nM * nN; G = G_; c = c_; }
    __device__ bool next(int i, Unit& u) const {
        const long L = (long)i * G + c; if (L >= nwg) return false;
        int wgid = (int)L; { const int q = nwg / NXCD, r = nwg % NXCD, xcd = wgid % NXCD, off = wgid / NXCD; wgid = (xcd < r ? xcd * (q + 1) : r * (q + 1) + (xcd - r) * q) + off; }
        const int nig = WGM * nN, gid = wgid / nig, fm = gid * WGM, gsz = (nM - fm) < WGM ? (nM - fm) : WGM;
        u.pm = fm + ((wgid % nig) % gsz); u.pn = (wgid % nig) / gsz; return true;
    }
};

template <class Epi>
__device__ __forceinline__ void gemm_phase(LAS unsigned char* lds, const Gemm g, const StaticOrder& S, const Epi& E, int wv) {
    const int tid = opaque_tid(wv), wid = __builtin_amdgcn_readfirstlane(tid >> 6), lane = tid & 63, wr = wid >> 2, wc = wid & 3, fr = lane & 15, fq = lane >> 4;
    const int K = g.K, nt = K / BK;
    unsigned voffA[2], voffB[2];
#pragma unroll
    for (int i = 0; i < 2; ++i) { int R, C; stage_rc(tid * 16 + i * 8192, R, C); const int Rb = Epi::PERM ? ((R & ~31) + perm32(R & 31)) : R;
        voffA[i] = (unsigned)(R * g.lda + C) * 2u; voffB[i] = (unsigned)(Rb * g.ldb + C) * 2u; }
    const size_t kstep = (size_t)(BK * 2);
    const size_t hstepA = (size_t)HALF * g.lda * 2, hstepB = (size_t)HALF * g.ldb * 2;
    const size_t tstepA = 2 * hstepA, tstepB = 2 * hstepB;
    const unsigned ldsw = (unsigned)wid * 1024u;
    const int aoff = lds_byte(wr * 64 + fr, fq * 8), boff = lds_byte(wc * 32 + fr, fq * 8);
#define PG8_SA(b, h) (((b) * 2 + (h)) * HTB)
#define PG8_SB(b, h) ((4 + (b) * 2 + (h)) * HTB)
#define PG8_STAGE(bufoff, gbase, voff) do { _Pragma("unroll") for (int _i = 0; _i < 2; ++_i) \
        __builtin_amdgcn_global_load_lds((const unsigned*)((const char*)(gbase) + (voff)[_i]), (LAS unsigned*)(lds + (bufoff) + ldsw + _i * 8192), 16, 0, 0); } while (0)
#define PG8_LDA(dst, b, h) do { _Pragma("unroll") for (int m = 0; m < 4; ++m) _Pragma("unroll") for (int k = 0; k < 2; ++k) dst[m][k] = *(const LAS bf16x8*)(lds + PG8_SA(b, h) + aoff + m * 2048 + k * 1024); } while (0)
#define PG8_LDB(dst, b, h) do { _Pragma("unroll") for (int n = 0; n < 2; ++n) _Pragma("unroll") for (int k = 0; k < 2; ++k) dst[n][k] = *(const LAS bf16x8*)(lds + PG8_SB(b, h) + boff + n * 2048 + k * 1024); } while (0)
#define PG8_MMA(ai, bj, At, Bt) do { __builtin_amdgcn_s_setprio(1); _Pragma("unroll") for (int m = 0; m < 4; ++m) _Pragma("unroll") for (int n = 0; n < 2; ++n) _Pragma("unroll") for (int k = 0; k < 2; ++k) \
        acc[ai][bj][m][n] = __builtin_amdgcn_mfma_f32_16x16x32_bf16(Bt[n][k], At[m][k], acc[ai][bj][m][n], 0, 0, 0); __builtin_amdgcn_s_setprio(0); } while (0)
#define PG8_WAIT_V(n) asm volatile("s_waitcnt vmcnt(" #n ")" ::: "memory")
#define PG8_WAIT_L(n) asm volatile("s_waitcnt lgkmcnt(" #n ")" ::: "memory")
#define PG8_BAR __builtin_amdgcn_s_barrier()
#define PG8_SCHED __builtin_amdgcn_sched_barrier(0)
    Unit cur, nxt; int ui = 0;
    if (!S.next(0, cur)) return;
    f32x4 acc[2][2][4][2];
    if constexpr (Epi::INIT) E.init(acc, cur, wr, wc, fr, fq); else {
#pragma unroll
    for (int a = 0; a < 2; ++a)
#pragma unroll
        for (int b = 0; b < 2; ++b)
#pragma unroll
            for (int m = 0; m < 4; ++m)
#pragma unroll
                for (int n = 0; n < 2; ++n) acc[a][b][m][n] = (f32x4){0.f, 0.f, 0.f, 0.f};
    }
    bf16x8 At[4][2], B0[2][2], B1[2][2];
    const char* cA = (const char*)g.A + (size_t)cur.pm * tstepA; const char* cB = (const char*)g.Bt + (size_t)cur.pn * tstepB;
    PG8_STAGE(PG8_SB(0, 0), cB, voffB); PG8_STAGE(PG8_SA(0, 0), cA, voffA); PG8_STAGE(PG8_SB(0, 1), cB + hstepB, voffB); PG8_STAGE(PG8_SA(0, 1), cA + hstepA, voffA);
    if (wr == 1) PG8_BAR;
    PG8_WAIT_V(4); PG8_BAR;
    PG8_STAGE(PG8_SB(1, 0), cB + kstep, voffB); PG8_STAGE(PG8_SA(1, 0), cA + kstep, voffA); PG8_STAGE(PG8_SB(1, 1), cB + hstepB + kstep, voffB);
    PG8_WAIT_V(6); PG8_BAR;
    for (;;) {
        const bool has_next = S.next(ui + 1, nxt);
        const char* nA = has_next ? (const char*)g.A + (size_t)nxt.pm * tstepA : cA; const char* nB = has_next ? (const char*)g.Bt + (size_t)nxt.pn * tstepB : cB;
        for (int t = 0; t < nt; t += 2) {
            const bool last = (t == nt - 2);
            const char* a1 = cA + (size_t)(t + 1) * kstep;
            const char* a2 = last ? nA : cA + (size_t)(t + 2) * kstep; const char* b2 = last ? nB : cB + (size_t)(t + 2) * kstep;
            const char* a3 = a2 + kstep; const char* b3 = b2 + kstep;
            PG8_LDB(B0, 0, 0); PG8_SCHED; PG8_LDA(At, 0, 0); PG8_STAGE(PG8_SA(1, 1), a1 + hstepA, voffA);
            PG8_WAIT_L(8); PG8_BAR; PG8_WAIT_L(0); PG8_MMA(0, 0, At, B0); PG8_BAR; PG8_SCHED;
            PG8_LDB(B1, 0, 1); PG8_STAGE(PG8_SB(0, 0), b2, voffB);
            PG8_BAR; PG8_WAIT_L(0); PG8_MMA(0, 1, At, B1); PG8_BAR;
            PG8_LDA(At, 0, 1); PG8_STAGE(PG8_SA(0, 0), a2, voffA);
            PG8_BAR; PG8_WAIT_L(0); PG8_MMA(1, 0, At, B0); PG8_BAR; PG8_SCHED;
            PG8_STAGE(PG8_SB(0, 1), b2 + hstepB, voffB);
            PG8_WAIT_V(6); PG8_BAR; PG8_MMA(1, 1, At, B1); PG8_BAR;
            PG8_LDB(B0, 1, 0); PG8_SCHED; PG8_LDA(At, 1, 0); PG8_STAGE(PG8_SA(0, 1), a2 + hstepA, voffA);
            PG8_WAIT_L(8); PG8_BAR; PG8_WAIT_L(0); PG8_MMA(0, 0, At, B0); PG8_BAR; PG8_SCHED;
            PG8_LDB(B1, 1, 1); PG8_STAGE(PG8_SB(1, 0), b3, voffB);
            PG8_BAR; PG8_WAIT_L(0); PG8_MMA(0, 1, At, B1); PG8_BAR;
            PG8_LDA(At, 1, 1); PG8_STAGE(PG8_SA(1, 0), a3, voffA);
            PG8_BAR; PG8_WAIT_L(0); PG8_MMA(1, 0, At, B0); PG8_BAR; PG8_SCHED;
            PG8_STAGE(PG8_SB(1, 1), b3 + hstepB, voffB);
            PG8_WAIT_V(6); PG8_BAR; PG8_MMA(1, 1, At, B1); PG8_BAR;
        }
        { int fr2 = fr, fq2 = fq, wr2 = wr, wc2 = wc; asm volatile("" : "+v"(fr2), "+v"(fq2), "+s"(wr2), "+s"(wc2)); E(acc, cur, wr2, wc2, fr2, fq2); }
        if (!has_next) break;
        if constexpr (Epi::INIT) E.init(acc, nxt, wr, wc, fr, fq); else {
#pragma unroll
        for (int a = 0; a < 2; ++a)
#pragma unroll
            for (int b = 0; b < 2; ++b)
#pragma unroll
                for (int m = 0; m < 4; ++m)
#pragma unroll
                    for (int n = 0; n < 2; ++n) acc[a][b][m][n] = (f32x4){0.f, 0.f, 0.f, 0.f};
        }
        cur = nxt; cA = nA; cB = nB; ++ui;
    }
    PG8_WAIT_V(0);
    if (wr == 0) PG8_BAR;
    PG8_BAR;
#undef PG8_SA
#undef PG8_SB
#undef PG8_STAGE
#undef PG8_LDA
#undef PG8_LDB
#undef PG8_MMA
#undef PG8_WAIT_V
#undef PG8_WAIT_L
#undef PG8_BAR
#undef PG8_SCHED
}
}
using pg8::Unit;

__device__ __forceinline__ void row_rstd(float (&rs)[2][4], const float* slots, int nslot4, float invK, int row0, int fq) {
#pragma unroll
    for (int ai = 0; ai < 2; ++ai)
#pragma unroll
        for (int m = 0; m < 4; ++m) {
            const int row = row0 + ai * 128 + m * 16; float s = 0.f;
            if (fq < nslot4) { const f32x4 v = *(const f32x4*)(slots + (size_t)row * 16 + 4 * fq); s = (v[0] + v[1]) + (v[2] + v[3]); }
            s = xor16_sum(s); s = xor32_sum(s);
            rs[ai][m] = rsqrtf(s * invK + EPS);
        }
}
__device__ __forceinline__ float sumsq4(f32x4 v) { return (v[0] * v[0] + v[1] * v[1]) + (v[2] * v[2] + v[3] * v[3]); }
__device__ __forceinline__ void rope8(f32x4& v0, f32x4& v1, int pos, int pair0, const float* invf) {
    const float fp = (float)pos; float sn, cs;
    sincos_acc(fp * invf[pair0 + 0], sn, cs); { const float a = v0[0], b = v0[1]; v0[0] = a * cs - b * sn; v0[1] = b * cs + a * sn; }
    sincos_acc(fp * invf[pair0 + 1], sn, cs); { const float a = v0[2], b = v0[3]; v0[2] = a * cs - b * sn; v0[3] = b * cs + a * sn; }
    sincos_acc(fp * invf[pair0 + 2], sn, cs); { const float a = v1[0], b = v1[1]; v1[0] = a * cs - b * sn; v1[1] = b * cs + a * sn; }
    sincos_acc(fp * invf[pair0 + 3], sn, cs); { const float a = v1[2], b = v1[3]; v1[2] = a * cs - b * sn; v1[3] = b * cs + a * sn; }
}
enum { M_MLAIN = 0, M_Q = 1, M_PLAIN = 2, M_GLAIN = 3, M_SQRELU = 4 };
template <int MODE> struct EpiRow {
    static constexpr bool PERM = true, INIT = false, LDSR = true;
    bf16_t* O; int ldc; const float* slots; int nslot4; float invK;
    float* ssq_a; float* ssq_b; float* abuf; const int* pos; const float* invf;
    const LAS float* lr; int pm0;
    __device__ __forceinline__ void operator()(const f32x4 (&acc)[2][2][4][2], const Unit& u, int wr, int wc, int fr, int fq) const {
        const int row0 = u.pm * 256 + wr * 64 + fr;
        float rs[2][4];
        if (u.pm == pm0) {
#pragma unroll
            for (int ai = 0; ai < 2; ++ai)
#pragma unroll
                for (int m = 0; m < 4; ++m) rs[ai][m] = lr[wr * 64 + fr + ai * 128 + m * 16];
        } else row_rstd(rs, slots, nslot4, invK, row0, fq);
        const int colw = u.pn * 256 + wc * 32;
#pragma unroll
        for (int ai = 0; ai < 2; ++ai)
#pragma unroll
            for (int m = 0; m < 4; ++m) {
                const int row = row0 + ai * 128 + m * 16; const float r = rs[ai][m];
                float ss0 = 0.f, ss1 = 0.f;
#pragma unroll
                for (int bj = 0; bj < 2; ++bj) {
                    f32x4 v0 = acc[ai][bj][m][0] * r, v1 = acc[ai][bj][m][1] * r;
                    const int col = colw + bj * 128 + 8 * fq;
                    if (MODE == M_MLAIN) {
                        const float q = sumsq4(v0) + sumsq4(v1); if (bj == 0) ss0 = q; else ss1 = q;
                        if (u.pn == 2 && bj == 1 && wc < 2) rope8(v0, v1, pos[row], (wc * 32 + 8 * fq) >> 1, invf);
                    }
                    if (MODE == M_SQRELU) {
#pragma unroll
                        for (int j = 0; j < 4; ++j) { const float a = fmaxf(v0[j], 0.f), b = fmaxf(v1[j], 0.f); v0[j] = a * a; v1[j] = b * b; }
                    }
                    if (MODE == M_GLAIN && u.pn == 12) {
                        if (bj == 0 && wc == 0 && fq < 2) { *(f32x4*)(abuf + (size_t)row * 16 + 8 * fq) = v0; *(f32x4*)(abuf + (size_t)row * 16 + 8 * fq + 4) = v1; }
                    } else {
                        u32x4 w; w.x = cvt_pk_bf16(v0[0], v0[1]); w.y = cvt_pk_bf16(v0[2], v0[3]); w.z = cvt_pk_bf16(v1[0], v1[1]); w.w = cvt_pk_bf16(v1[2], v1[3]);
                        *(u32x4*)(O + (size_t)row * ldc + col) = w;
                    }
                }
                if (MODE == M_MLAIN) {
                    float sa = (u.pn == 2) ? ss0 : ss0 + ss1;
                    sa = xor16_sum(sa); sa = xor32_sum(sa);
                    if (fq == 0) { if (u.pn == 0) ssq_a[(size_t)row * 16 + wc] = sa; else ssq_b[(size_t)row * 16 + (u.pn - 1) * 4 + wc] = sa; }
                }
            }
    }
};
struct EpiVT {
    static constexpr bool PERM = true, INIT = false, LDSR = false;
    bf16_t* O; const float* slots; float invK;
    __device__ __forceinline__ void operator()(const f32x4 (&acc)[2][2][4][2], const Unit& u, int wr, int wc, int fr, int fq) const {
        const int row0 = u.pm * 256 + wr * 64 + fr;
#pragma unroll
        for (int bj = 0; bj < 2; ++bj) {
            const int c0 = u.pn * 256 + bj * 128 + wc * 32 + 8 * fq; float rt[8];
#pragma unroll
            for (int t = 0; t < 8; ++t) { const f32x4 v = *(const f32x4*)(slots + (size_t)(c0 + t) * 16); rt[t] = rsqrtf(((v[0] + v[1]) + (v[2] + v[3])) * invK + EPS); }
#pragma unroll
            for (int ai = 0; ai < 2; ++ai)
#pragma unroll
                for (int m = 0; m < 4; ++m) {
                    const int row = row0 + ai * 128 + m * 16; const f32x4 v0 = acc[ai][bj][m][0], v1 = acc[ai][bj][m][1];
                    u32x4 w; w.x = cvt_pk_bf16(v0[0] * rt[0], v0[1] * rt[1]); w.y = cvt_pk_bf16(v0[2] * rt[2], v0[3] * rt[3]); w.z = cvt_pk_bf16(v1[0] * rt[4], v1[1] * rt[5]); w.w = cvt_pk_bf16(v1[2] * rt[6], v1[3] * rt[7]);
                    const int t0 = c0 & 31, pb = t0 >> 4, pw = (t0 >> 2) & 3; bf16_t* dst = O + (size_t)row * S + (c0 & ~31) + 4 * pb;
                    *(u32x2*)(dst + 8 * pw) = (u32x2){w.x, w.y}; *(u32x2*)(dst + 8 * (pw + 1)) = (u32x2){w.z, w.w};
                }
        }
    }
};
struct EpiRes {
    static constexpr bool PERM = true, INIT = true, LDSR = false;
    bf16_t* xb; float* ssq;
    __device__ __forceinline__ void init(f32x4 (&acc)[2][2][4][2], const Unit& u, int wr, int wc, int fr, int fq) const {
        const int row0 = u.pm * 256 + wr * 64 + fr, col0 = u.pn * 256 + wc * 32 + 8 * fq;
#pragma unroll
        for (int ai = 0; ai < 2; ++ai)
#pragma unroll
            for (int m = 0; m < 4; ++m)
#pragma unroll
                for (int bj = 0; bj < 2; ++bj) {
                    const bf16x8 old = *(const bf16x8*)(xb + (size_t)(row0 + ai * 128 + m * 16) * D + col0 + bj * 128);
#pragma unroll
                    for (int i = 0; i < 4; ++i) { acc[ai][bj][m][0][i] = bf2f((bf16_t)old[i]); acc[ai][bj][m][1][i] = bf2f((bf16_t)old[4 + i]); }
                }
    }
    __device__ __forceinline__ void operator()(const f32x4 (&acc)[2][2][4][2], const Unit& u, int wr, int wc, int fr, int fq) const {
        const int row0 = u.pm * 256 + wr * 64 + fr, col0 = u.pn * 256 + wc * 32 + 8 * fq;
#pragma unroll
        for (int ai = 0; ai < 2; ++ai)
#pragma unroll
            for (int m = 0; m < 4; ++m) {
                const int row = row0 + ai * 128 + m * 16; float ss = 0.f;
#pragma unroll
                for (int bj = 0; bj < 2; ++bj) {
                    const f32x4 o0 = acc[ai][bj][m][0], o1 = acc[ai][bj][m][1];
                    ss += sumsq4(o0) + sumsq4(o1);
                    *(bf16x8*)(xb + (size_t)row * D + col0 + bj * 128) = pack8(o0, o1);
                }
                ss = xor16_sum(ss); ss = xor32_sum(ss);
                if (fq == 0) ssq[(size_t)row * 16 + u.pn * 4 + wc] = ss;
            }
    }
};
template <class Epi> __device__ __forceinline__ void run_gemm(LAS unsigned char* lds, const bf16_t* A, int lda, const bf16_t* Bt, int ldb, int M, int N, int K, const Epi& E, int rot, int wv) {
    pg8::Gemm g{A, Bt, M, N, K, lda, ldb}; pg8::StaticOrder So; So.init(M, N, (int)gridDim.x, (int)((blockIdx.x + rot) % gridDim.x));
    if constexpr (Epi::LDSR) {
        Epi E2 = E; Unit u0; const bool has = So.next(0, u0); LAS float* lr = (LAS float*)(lds + 131072);
        if (has) { const int tid = opaque_tid(wv);
            if (tid < 256) { const float* sp = E.slots + (size_t)(u0.pm * 256 + tid) * 16; float s = 0.f;
                for (int i = 0; i < E.nslot4; ++i) { const f32x4 v = *(const f32x4*)(sp + 4 * i); s += (v[0] + v[1]) + (v[2] + v[3]); }
                lr[tid] = rsqrtf(s * E.invK + EPS); } }
        __syncthreads();
        E2.lr = lr; E2.pm0 = has ? u0.pm : -1;
        pg8::gemm_phase<Epi>(lds, g, So, E2, wv);
    } else pg8::gemm_phase<Epi>(lds, g, So, E, wv);
}

enum { CM_PLAIN = 0, CM_MLAIN = 1, CM_UQ = 2, CM_UK = 3, CM_UV = 4 };
__device__ __forceinline__ int colmap(int kind, int n, int Nsrc) {
    switch (kind) {
        case CM_MLAIN: { if (n < 256) return 384 + n; if (n < 640) return n - 256; if (n < 704) { const int j = n - 640; return 640 + (j >> 1) + 32 * (j & 1); } return -1; }
        case CM_UQ: { const int h = n / 192, r = n % 192; if (r < 128) return h * 192 + r; const int j = r - 128; return h * 192 + 128 + (j >> 1) + 32 * (j & 1); }
        case CM_UK: return (n >> 7) * 256 + (n & 127);
        case CM_UV: return (n >> 7) * 256 + 128 + (n & 127);
        default: return n < Nsrc ? n : -1;
    }
}
__device__ __forceinline__ void conv_w(LAS unsigned char* lds, int kind, const float* src, int K, int Nsrc, bf16_t* dst, int Ndst, const float* gain, float fac, int rot, int wv, int wgi, int nwgi) {
    LAS float* tile = (LAS float*)lds;
    const int tid = opaque_tid(wv), ntk = K / 64, ntn = Ndst / 64, nwg = nwgi, wg = (wgi + rot) % nwg;
    for (int t = wg; t < ntk * ntn; t += nwg) {
        const int kt = t % ntk, nt_ = t / ntk;
        const int nn = tid & 63, sc = colmap(kind, nt_ * 64 + nn, Nsrc);
#pragma unroll
        for (int j = 0; j < 8; ++j) { const int kk = (tid >> 6) + 8 * j, k = kt * 64 + kk; float v = 0.f; if (sc >= 0) { v = src[(size_t)k * Nsrc + sc] * fac; if (gain) v *= gain[k]; } tile[kk * 65 + nn] = v; }
        __syncthreads();
        { const int n = tid >> 3, k8 = (tid & 7) * 8; f32x4 a, b;
#pragma unroll
          for (int j = 0; j < 4; ++j) { a[j] = tile[(k8 + j) * 65 + n]; b[j] = tile[(k8 + 4 + j) * 65 + n]; }
          *(bf16x8*)(dst + (size_t)(nt_ * 64 + n) * K + kt * 64 + k8) = pack8(a, b); }
        __syncthreads();
    }
}
__device__ __forceinline__ void conv_plain(const float* src, int K, int Nsrc, bf16_t* dst, int Ndst, const float* gain, int rot, int wv, int wgi, int nwgi) {
    const int tid = opaque_tid(wv), lane = tid & 63, k8 = lane & 7, n4 = lane >> 3;
    const int ntk = K / 64, ntn = Ndst / 32, nw = nwgi * 8, w = ((wgi + rot) % nwgi) * 8 + (tid >> 6);
    for (int t = w; t < ntk * ntn; t += nw) {
        const int kt = t % ntk, nt_ = t / ntk, n = nt_ * 32 + 4 * n4, k = kt * 64 + 8 * k8;
        f32x4 v[8];
        if (n < Nsrc) {
#pragma unroll
            for (int i = 0; i < 8; ++i) v[i] = __builtin_nontemporal_load((const f32x4*)(src + (size_t)(k + i) * Nsrc + n));
            if (gain) {
                const f32x4 g0 = *(const f32x4*)(gain + k), g1 = *(const f32x4*)(gain + k + 4);
#pragma unroll
                for (int i = 0; i < 4; ++i) { v[i] *= g0[i]; v[4 + i] *= g1[i]; }
            }
        } else {
#pragma unroll
            for (int i = 0; i < 8; ++i) v[i] = (f32x4){0.f, 0.f, 0.f, 0.f};
        }
#pragma unroll
        for (int j = 0; j < 4; ++j)
            *(bf16x8*)(dst + (size_t)(n + j) * K + k) = pack8((f32x4){v[0][j], v[1][j], v[2][j], v[3][j]}, (f32x4){v[4][j], v[5][j], v[6][j], v[7][j]});
    }
}
struct ConvJob { int kind; const float* src; int K, Nsrc; bf16_t* dst; int Ndst; const float* gain; float fac; int rot; };
__device__ __forceinline__ bool get_job(CParams& p, int layer, int which, int ji, ConvJob& J) {
    bf16_t* wm = (bf16_t*)(p.ws + WS_WMIX); bf16_t* wl = (bf16_t*)(p.ws + WS_WMLP); const int j = layer >> 1;
    if (which == 1) {
        if (ji == 0) { J = ConvJob{CM_PLAIN, p.mlp_w_up + (size_t)layer * D * DFF, D, DFF, wl, DFF, p.norm_mlp + layer * D, 1.f, 0}; return true; }
        if (ji == 1) { J = ConvJob{CM_PLAIN, p.mlp_w_down + (size_t)layer * D * DFF, DFF, D, wl + (size_t)DFF * D, D, nullptr, 1.f, 0}; return true; }
        return false;
    }
    const float* gmix = p.norm_mix + layer * D;
    if ((layer & 1) == 0) {
        switch (ji) {
            case 0: J = ConvJob{CM_MLAIN, p.mla_w_in + (size_t)j * 1024 * 704, 1024, 704, wm + WM_IN, 768, gmix, 1.f, 0}; return true;
            case 1: J = ConvJob{CM_UQ, p.mla_w_uq + (size_t)j * 384 * 1536, 384, 1536, wm + WM_UQ, 1536, p.mla_q_norm + j * 384, 0.07216878364870323f * 1.4426950408889634f, 192}; return true;
            case 2: J = ConvJob{CM_UK, p.mla_w_ukv + (size_t)j * 256 * 2048, 256, 2048, wm + WM_UK, 1024, p.mla_kv_norm + j * 256, 1.f, 80}; return true;
            case 3: J = ConvJob{CM_UV, p.mla_w_ukv + (size_t)j * 256 * 2048, 256, 2048, wm + WM_UV, 1024, p.mla_kv_norm + j * 256, 1.f, 144}; return true;
            case 4: J = ConvJob{CM_PLAIN, p.mla_w_o + (size_t)j * 1024 * 1024, 1024, 1024, wm + WM_O_MLA, 1024, nullptr, 1.f, 208}; return true;
            default: return false;
        }
    } else {
        if (ji == 0) { J = ConvJob{CM_PLAIN, p.gla_w_in + (size_t)j * 1024 * 3088, 1024, 3088, wm + WM_IN, 3328, gmix, 1.f, 0}; return true; }
        if (ji == 1) { J = ConvJob{CM_PLAIN, p.gla_w_o + (size_t)j * 1024 * 1024, 1024, 1024, wm + WM_O_GLA, 1024, nullptr, 1.f, 64}; return true; }
        return false;
    }
}
__device__ __forceinline__ void conv_run(CParams& p, LAS unsigned char* lds, int layer, int which, int wv, int wgi, int nwgi) {
    for (int ji = 0; ji < 5; ++ji) { ConvJob J; if (!get_job(p, layer, which, ji, J)) break; if (J.kind == CM_PLAIN) conv_plain(J.src, J.K, J.Nsrc, J.dst, J.Ndst, J.gain, J.rot, wv, wgi, nwgi); else conv_w(lds, J.kind, J.src, J.K, J.Nsrc, J.dst, J.Ndst, J.gain, J.fac, J.rot, wv, wgi, nwgi); }
}
__device__ __forceinline__ void conv_mixer(CParams& p, LAS unsigned char* lds, int layer, int wv) { conv_run(p, lds, layer, 0, wv, (int)blockIdx.x, (int)gridDim.x); }
__device__ __forceinline__ void conv_mlp(CParams& p, LAS unsigned char* lds, int layer, int wv) { conv_run(p, lds, layer, 1, wv, (int)blockIdx.x, (int)gridDim.x); }
__device__ __forceinline__ void conv_mlp_weighted(CParams& p, LAS unsigned char* lds, int layer, int wv, int nbusy) {
    const int G = (int)gridDim.x, b = (int)blockIdx.x;
    if (nbusy >= G) { conv_run(p, lds, layer, 1, wv, b, G); return; }
    const int nv = nbusy + 3 * (G - nbusy);
    if (b < nbusy) conv_run(p, lds, layer, 1, wv, b, nv);
    else for (int t = 0; t < 3; ++t) conv_run(p, lds, layer, 1, wv, nbusy + 3 * (b - nbusy) + t, nv);
}

__device__ __forceinline__ void prologue_x(CParams& p, int wv) {
    const int tid = opaque_tid(wv), lane = tid & 63, gw = blockIdx.x * 8 + (tid >> 6), nw = gridDim.x * 8;
    bf16_t* xb = (bf16_t*)(p.ws + WS_XB); float* ssq = (float*)(p.ws + WS_SSQX);
    f32x4 v[4], vn[4];
    if (gw < S) {
#pragma unroll
        for (int i = 0; i < 4; ++i) v[i] = *(const f32x4*)(p.x + (size_t)gw * D + i * 256 + lane * 4); }
    for (int row = gw; row < S; row += nw) {
        const int nr = row + nw;
        if (nr < S) {
#pragma unroll
            for (int i = 0; i < 4; ++i) vn[i] = *(const f32x4*)(p.x + (size_t)nr * D + i * 256 + lane * 4); }
        float ss = 0.f;
#pragma unroll
        for (int i = 0; i < 4; ++i) { ss += sumsq4(v[i]); u32x2 w; w.x = cvt_pk_bf16(v[i][0], v[i][1]); w.y = cvt_pk_bf16(v[i][2], v[i][3]); *(u32x2*)(xb + (size_t)row * D + i * 256 + lane * 4) = w; }
        ss = wave_sum(ss);
        if (lane < 16) ssq[(size_t)row * 16 + lane] = (lane == 0) ? ss : 0.f;
#pragma unroll
        for (int i = 0; i < 4; ++i) v[i] = vn[i];
    }
    if (blockIdx.x == 0 && tid < 32) { float* f = (float*)(p.ws + WS_INVF); f[tid] = 1.0f / powf(10000.0f, (float)(2 * tid) * (1.0f / 64.0f)); }
}
__device__ __forceinline__ void final_norm(CParams& p, int wv) {
    const int tid = opaque_tid(wv), lane = tid & 63, gw = blockIdx.x * 8 + (tid >> 6), nw = gridDim.x * 8;
    const bf16_t* xbp = (const bf16_t*)(p.ws + WS_XB);
    f32x4 g[4];
#pragma unroll
    for (int i = 0; i < 2; ++i) { g[2 * i] = *(const f32x4*)(p.final_norm + i * 512 + lane * 8); g[2 * i + 1] = *(const f32x4*)(p.final_norm + i * 512 + lane * 8 + 4); }
    bf16x8 t[2], tn[2];
    if (gw < S) { t[0] = *(const bf16x8*)(xbp + (size_t)gw * D + lane * 8); t[1] = *(const bf16x8*)(xbp + (size_t)gw * D + 512 + lane * 8); }
    for (int row = gw; row < S; row += nw) {
        const int nr = row + nw;
        if (nr < S) { tn[0] = *(const bf16x8*)(xbp + (size_t)nr * D + lane * 8); tn[1] = *(const bf16x8*)(xbp + (size_t)nr * D + 512 + lane * 8); }
        float* orow = p.out + (size_t)row * D; f32x4 v[4]; float ss = 0.f;
#pragma unroll
        for (int i = 0; i < 2; ++i) {
#pragma unroll
            for (int q = 0; q < 4; ++q) { v[2 * i][q] = bf2f((bf16_t)t[i][q]); v[2 * i + 1][q] = bf2f((bf16_t)t[i][4 + q]); }
            ss += sumsq4(v[2 * i]) + sumsq4(v[2 * i + 1]); }
        ss = wave_sum(ss);
        const float r = rsqrtf(ss * (1.0f / D) + EPS);
#pragma unroll
        for (int i = 0; i < 2; ++i) { *(f32x4*)(orow + i * 512 + lane * 8) = v[2 * i] * r * g[2 * i]; *(f32x4*)(orow + i * 512 + lane * 8 + 4) = v[2 * i + 1] * r * g[2 * i + 1]; }
        t[0] = tn[0]; t[1] = tn[1];
    }
}

constexpr int KROW = 400, VROW = 144, KTILE_B = 64 * KROW, VTILE_B = 128 * VROW, ATT_BUF = KTILE_B + VTILE_B;
__device__ __forceinline__ void attn_phase(CParams& p, LAS unsigned char* lds, int wv) {
    const int tid = opaque_tid(wv), wid = __builtin_amdgcn_readfirstlane(tid >> 6), lane_w = tid & 63;
    const bf16_t* qbp = (const bf16_t*)(p.ws + R_QB); bf16_t* ob = (bf16_t*)(p.ws + R_OB);
    for (int item = blockIdx.x; item < 256; item += gridDim.x) {
        const int h = item & 7, pr = item >> 3;
        for (int half = 0; half < 2; ++half) {
            int lane_o = lane_w; asm volatile("" : "+v"(lane_o));
            const int lane = lane_o, j16 = lane & 15, quad = lane >> 4, gsw = ((j16 >> 2) ^ (j16 >> 3)) & 1, kgx = quad ^ gsw;
            const int qblk = half == 0 ? 63 - pr : pr, ntile = 4 * qblk + 4;
            const int q0 = qblk * 256 + wid * 32, last_tile = (q0 + 31) >> 6;
            unsigned goff[6], gstr[6];
#pragma unroll
            for (int j = 0; j < 6; ++j) {
                const int g = (wid + 8 * j) * 64 + lane;
                if (g < 1600) { const int row = g / 25, sc = g % 25, cc = sc < 24 ? (sc ^ (((row >> 2) ^ (row >> 3)) & 1)) : 0;
                    if (cc >= 16) { goff[j] = (unsigned)R_HB + (unsigned)(row * 768 + 640 + (cc - 16) * 8) * 2u; gstr[j] = 64u * 768u * 2u; }
                    else { goff[j] = (unsigned)R_KN + (unsigned)(row * 1024 + h * 128 + cc * 8) * 2u; gstr[j] = 64u * 1024u * 2u; } }
                else { const int g2 = g - 1600, d = g2 / 9, sc = g2 % 9, cc = sc < 8 ? (sc ^ (((d >> 2) ^ (d >> 3)) & 1)) : 0;
                    goff[j] = (unsigned)R_VT + (unsigned)((h * 128 + d) * S + cc * 8) * 2u; gstr[j] = 128u; }
            }
            __builtin_amdgcn_sched_barrier(0);
            bf16x8 qf[2][6];
#pragma unroll
            for (int qb = 0; qb < 2; ++qb)
#pragma unroll
                for (int s = 0; s < 6; ++s) qf[qb][s] = *(const bf16x8*)(qbp + (size_t)(q0 + 16 * qb + j16) * 1536 + h * 192 + 32 * s + 8 * quad);
            { const float* invf = (const float*)(p.ws + WS_INVF);
#pragma unroll
              for (int qb = 0; qb < 2; ++qb) { const int qpos = p.pos[q0 + 16 * qb + j16];
#pragma unroll
                for (int s = 4; s < 6; ++s) {
                  f32x4 v0, v1; for (int i = 0; i < 4; ++i) { v0[i] = bf2f((bf16_t)qf[qb][s][i]); v1[i] = bf2f((bf16_t)qf[qb][s][4 + i]); }
                  rope8(v0, v1, qpos, 16 * (s - 4) + 4 * quad, invf); qf[qb][s] = pack8(v0, v1); __builtin_amdgcn_sched_barrier(0); } } }
            f32x4 o[8][2];
#pragma unroll
            for (int db = 0; db < 8; ++db) { o[db][0] = (f32x4){0.f, 0.f, 0.f, 0.f}; o[db][1] = (f32x4){0.f, 0.f, 0.f, 0.f}; }
            float mrun[2] = {0.f, 0.f}, lrun[2] = {0.f, 0.f};
            f32x4 negm[2] = {(f32x4){0.f, 0.f, 0.f, 0.f}, (f32x4){0.f, 0.f, 0.f, 0.f}};
            const int nld = wid < 3 ? 6 : 5;
#define ATT_ISSUE(slot_) do { _Pragma("unroll") for (int j = 0; j < 6; ++j) if (j < nld) { \
                __builtin_amdgcn_global_load_lds((const unsigned*)(p.ws + goff[j]), (LAS unsigned*)(lds + (slot_) * ATT_BUF + (wid + 8 * j) * 1024), 16, 0, 0); goff[j] += gstr[j]; } } while (0)
            ATT_ISSUE(0);
            if (ntile > 1) ATT_ISSUE(1);
            int slot = 0;
            for (int kt = 0; kt < ntile; ++kt) {
                const int cur = slot * ATT_BUF;
                if (kt + 1 < ntile) { if (wid < 3) asm volatile("s_waitcnt vmcnt(6)" ::: "memory"); else asm volatile("s_waitcnt vmcnt(5)" ::: "memory"); }
                else asm volatile("s_waitcnt vmcnt(0)" ::: "memory");
                __builtin_amdgcn_s_barrier();
                asm volatile("" ::: "memory");
                if (kt + 2 < ntile) { const int s2 = slot == 0 ? 2 : slot - 1; ATT_ISSUE(s2); }
                if (kt <= last_tile) {
                    f32x4 sa[4][2];
                    const LAS unsigned char* kbase = lds + cur + j16 * KROW + 16 * kgx;
#pragma unroll
                    for (int s = 0; s < 6; ++s)
#pragma unroll
                        for (int kb = 0; kb < 4; ++kb) {
                            const bf16x8 kf = *(const LAS bf16x8*)(kbase + kb * 16 * KROW + 64 * s);
                            sa[kb][0] = mfma16(kf, qf[0][s], s == 0 ? negm[0] : sa[kb][0]); sa[kb][1] = mfma16(kf, qf[1][s], s == 0 ? negm[1] : sa[kb][1]);
                        }
                    if (kt * 64 + 63 > q0) {
                        const float NEG = -__builtin_inff();
#pragma unroll
                        for (int qb = 0; qb < 2; ++qb) { const int dq = q0 + 16 * qb + j16 - kt * 64 - 4 * quad;
#pragma unroll
                            for (int kb = 0; kb < 4; ++kb)
#pragma unroll
                                for (int r = 0; r < 4; ++r) if (16 * kb + r > dq) sa[kb][qb][r] = NEG; }
                    }
                    float tmax[2];
#pragma unroll
                    for (int qb = 0; qb < 2; ++qb) { float m = sa[0][qb][0];
#pragma unroll
                        for (int kb = 0; kb < 4; ++kb)
#pragma unroll
                            for (int r = 0; r < 4; ++r) m = fmaxf(m, sa[kb][qb][r]);
                        tmax[qb] = xor16_max(xor32_max(m)); }
                    if (kt == 0 || __builtin_amdgcn_ballot_w64(tmax[0] > 8.0f || tmax[1] > 8.0f) != 0ull) {
#pragma unroll
                        for (int qb = 0; qb < 2; ++qb) { const float d = kt == 0 ? tmax[qb] : fmaxf(tmax[qb], 0.f), alpha = kt == 0 ? 1.0f : __builtin_amdgcn_exp2f(-d); mrun[qb] += d; lrun[qb] *= alpha;
                            negm[qb] = (f32x4){-mrun[qb], -mrun[qb], -mrun[qb], -mrun[qb]};
#pragma unroll
                            for (int kb = 0; kb < 4; ++kb) sa[kb][qb] -= d;
#pragma unroll
                            for (int db = 0; db < 8; ++db) o[db][qb] *= alpha; }
                    }
#pragma unroll
                    for (int qb = 0; qb < 2; ++qb) { float ps = 0.f;
#pragma unroll
                        for (int kb = 0; kb < 4; ++kb)
#pragma unroll
                            for (int r = 0; r < 4; ++r) { const float e = __builtin_amdgcn_exp2f(sa[kb][qb][r]); sa[kb][qb][r] = e; ps += e; }
                        lrun[qb] += ps; }
                    bf16x8 pfr[2][2];
#pragma unroll
                    for (int qb = 0; qb < 2; ++qb) { pfr[qb][0] = pack8(sa[0][qb], sa[1][qb]); pfr[qb][1] = pack8(sa[2][qb], sa[3][qb]); }
                    const LAS unsigned char* vbase = lds + cur + KTILE_B + j16 * VROW + 16 * kgx;
#pragma unroll
                    for (int ks = 0; ks < 2; ++ks)
#pragma unroll
                        for (int db = 0; db < 8; ++db) {
                            const bf16x8 vf = *(const LAS bf16x8*)(vbase + db * 16 * VROW + 64 * ks);
                            o[db][0] = mfma16(vf, pfr[0][ks], o[db][0]); o[db][1] = mfma16(vf, pfr[1][ks], o[db][1]);
                        }
                }
                slot = slot == 2 ? 0 : slot + 1;
            }
#undef ATT_ISSUE
            asm volatile("s_waitcnt lgkmcnt(0)" ::: "memory");
            __builtin_amdgcn_s_barrier();
            asm volatile("" ::: "memory");
#pragma unroll
            for (int qb = 0; qb < 2; ++qb) {
                const float l = xor16_sum(xor32_sum(lrun[qb])), inv = 1.0f / l;
                bf16_t* orow = ob + (size_t)(q0 + 16 * qb + j16) * 1024 + h * 128 + 4 * quad;
#pragma unroll
                for (int db = 0; db < 8; ++db) { u32x2 w; w.x = cvt_pk_bf16(o[db][qb][0] * inv, o[db][qb][1] * inv); w.y = cvt_pk_bf16(o[db][qb][2] * inv, o[db][qb][3] * inv); *(u32x2*)(orow + 16 * db) = w; }
            }
        }
    }
}

constexpr int TROW = 72;
__device__ __forceinline__ void stage_vT(LAS bf16_t* vTl, const bf16_t* hg, int c, int h, int wv) {
    const int tid = opaque_tid(wv);
#pragma unroll
    for (int j = 0; j < 4; ++j) { const int ch = tid + 512 * j, t = ch >> 5, e8 = (ch & 31) * 8;
        const bf16x8 v = *(const bf16x8*)(hg + (size_t)(64 * c + t) * 3072 + 1024 + 256 * h + e8);
#pragma unroll
        for (int i = 0; i < 8; ++i) vTl[(e8 + i) * TROW + (t ^ (((e8 >> 3) & 7) << 3))] = (bf16_t)v[i]; }
}
__device__ __forceinline__ void gla_gate_proj(CParams& p, LAS unsigned char* lds, int wv) {
    const int tid = opaque_tid(wv), wid = __builtin_amdgcn_readfirstlane(tid >> 6), lane = tid & 63, c = lane & 31, hi = lane >> 5;
    const bf16_t* xbp = (const bf16_t*)(p.ws + WS_XB); const bf16_t* wa = (const bf16_t*)(p.ws + WS_WMIX) + (size_t)3072 * 1024;
    const float* ssq = (const float*)(p.ws + WS_SSQX); float* ab = (float*)(p.ws + R_AB);
    LAS float* part = (LAS float*)lds;
    for (int blk = blockIdx.x; blk < S / 64; blk += gridDim.x) {
        const int r0 = blk * 64;
        f32x16 acc0 = zero16(), acc1 = zero16();
#pragma unroll
        for (int s = 0; s < 8; ++s) {
            const int ko = 16 * (wid * 8 + s) + 8 * hi;
            const bf16x8 b = *(const bf16x8*)(wa + (size_t)(c & 15) * 1024 + ko);
            const bf16x8 a0 = *(const bf16x8*)(xbp + (size_t)(r0 + c) * 1024 + ko), a1 = *(const bf16x8*)(xbp + (size_t)(r0 + 32 + c) * 1024 + ko);
            acc0 = mfma32(a0, b, acc0); acc1 = mfma32(a1, b, acc1);
        }
        if (c < 16) {
#pragma unroll
            for (int r = 0; r < 16; ++r) { part[(wid * 64 + crow(r, hi)) * 16 + c] = acc0[r]; part[(wid * 64 + 32 + crow(r, hi)) * 16 + c] = acc1[r]; }
        }
        __syncthreads();
#pragma unroll
        for (int jj = 0; jj < 2; ++jj) {
            const int idx = tid + 512 * jj, row = idx >> 4, col = idx & 15; float s = 0.f;
#pragma unroll
            for (int w8 = 0; w8 < 8; ++w8) s += part[(w8 * 64 + row) * 16 + col];
            float q = 0.f;
#pragma unroll
            for (int i = 0; i < 4; ++i) { const f32x4 v = *(const f32x4*)(ssq + (size_t)(r0 + row) * 16 + 4 * i); q += (v[0] + v[1]) + (v[2] + v[3]); }
            ab[(size_t)(r0 + row) * 16 + col] = s * rsqrtf(q * (1.0f / 1024.0f) + EPS);
        }
        __syncthreads();
    }
}
__device__ __forceinline__ void gla_passA(CParams& p, LAS unsigned char* lds, int j, int wv) {
    const int tid = opaque_tid(wv), wid = __builtin_amdgcn_readfirstlane(tid >> 6), lane = tid & 63, c = lane & 31, hi = lane >> 5;
    LAS bf16_t* kTl = (LAS bf16_t*)lds; LAS bf16_t* vTl = (LAS bf16_t*)(lds + 128 * TROW * 2); LAS float* tot = (LAS float*)(lds + (128 + 256) * TROW * 2);
    bf16_t* hg = (bf16_t*)(p.ws + R_HG); const float* ab = (const float*)(p.ws + R_AB); bf16_t* U = (bf16_t*)(p.ws + R_U); float* dec = (float*)(p.ws + R_DEC);
    const float* Wg = p.gla_w_gk_up + (size_t)j * 16 * 512; const float* bg = p.gla_b_gk + j * 512;
    for (int item = blockIdx.x; item < 1024; item += gridDim.x) {
        const int ch = item >> 2, h = item & 3, d = tid & 127, tg = tid >> 7;
        float w[16];
#pragma unroll
        for (int r = 0; r < 16; ++r) w[r] = Wg[r * 512 + 128 * h + d];
        const float bias = bg[128 * h + d];
        float cum[16]; float run = 0.f;
        const size_t ro0 = (size_t)(64 * ch + 16 * tg) * 3072 + 128 * h + d;
        bf16_t qraw[16], kraw[16];
#pragma unroll
        for (int tt = 0; tt < 16; ++tt) { qraw[tt] = hg[ro0 + (size_t)tt * 3072]; kraw[tt] = hg[ro0 + (size_t)tt * 3072 + 512]; }
#pragma unroll
        for (int tt = 0; tt < 16; ++tt) {
            const float* ar = ab + (size_t)(64 * ch + 16 * tg + tt) * 16; float z = bias;
#pragma unroll
            for (int r4 = 0; r4 < 4; ++r4) { const f32x4 a = *(const f32x4*)(ar + 4 * r4); z += a[0] * w[4 * r4] + a[1] * w[4 * r4 + 1] + a[2] * w[4 * r4 + 2] + a[3] * w[4 * r4 + 3]; }
            const float ls = fminf(z, 0.f) - __logf(1.0f + __expf(-fabsf(z)));
            run += ls * 0.0625f; cum[tt] = run;
        }
        tot[tg * 128 + d] = run;
        __syncthreads();
        float off = 0.f, total = 0.f;
#pragma unroll
        for (int g = 0; g < 4; ++g) { const float t_ = tot[g * 128 + d]; total += t_; if (g < tg) off += t_; }
#pragma unroll
        for (int tt = 0; tt < 16; ++tt) {
            const float b = cum[tt] + off; const size_t ro = ro0 + (size_t)tt * 3072;
            const float qv = bf2f(qraw[tt]), kv = bf2f(kraw[tt]);
            const float eb = __expf(b), enb = __expf(-b);
            hg[ro] = f2bf(qv * 0.08838834764831845f * eb);
            hg[ro + 512] = f2bf(kv * enb);
            kTl[d * TROW + 16 * tg + tt] = f2bf(kv * __expf(total - b));
        }
        if (tg == 0) dec[(size_t)item * 128 + d] = __expf(total);
        stage_vT(vTl, hg, ch, h, wv);
        __syncthreads();
        f32x16 acc[4]; for (int i = 0; i < 4; ++i) acc[i] = zero16();
#pragma unroll
        for (int s = 0; s < 4; ++s) {
            const bf16x8 bf = *(const LAS bf16x8*)(vTl + (32 * wid + c) * TROW + (((2 * s + hi) ^ (((32 * wid + c) >> 3) & 7)) << 3));
#pragma unroll
            for (int db = 0; db < 4; ++db) { const bf16x8 af = *(const LAS bf16x8*)(kTl + (32 * db + c) * TROW + 16 * s + 8 * hi); acc[db] = mfma32(af, bf, acc[db]); }
        }
        bf16_t* up = U + ((size_t)item * 256 + 32 * wid + c) * 128;
#pragma unroll
        for (int db = 0; db < 4; ++db)
#pragma unroll
            for (int g = 0; g < 4; ++g) { u32x2 wv; wv.x = cvt_pk_bf16(acc[db][4 * g], acc[db][4 * g + 1]); wv.y = cvt_pk_bf16(acc[db][4 * g + 2], acc[db][4 * g + 3]); *(u32x2*)(up + 32 * db + 8 * g + 4 * hi) = wv; }
        __syncthreads();
    }
}
__device__ __forceinline__ void gla_scan(CParams& p, int wv) {
    bf16_t* U = (bf16_t*)(p.ws + R_U); const float* dec = (const float*)(p.ws + R_DEC);
    const int tid = opaque_tid(wv);
    for (int idx = blockIdx.x * NTHR + tid; idx < 4 * 256 * 128; idx += gridDim.x * NTHR) {
        const int h = idx >> 15, rem = idx & 32767, d = rem & 127;
        bf16_t* up = U + (size_t)h * 32768 + rem; const float* dp = dec + h * 128 + d; float st = 0.f;
        float u[32], dc[32], un[32], dn[32];
#pragma unroll
        for (int i = 0; i < 32; ++i) { u[i] = bf2f(up[(size_t)i * 131072]); dc[i] = dp[(size_t)i * 512]; }
        for (int c0 = 0; c0 < 256; c0 += 32) {
            if (c0 + 32 < 256) {
#pragma unroll
                for (int i = 0; i < 32; ++i) { un[i] = bf2f(up[(size_t)(c0 + 32 + i) * 131072]); dn[i] = dp[(size_t)(c0 + 32 + i) * 512]; }
            }
#pragma unroll
            for (int i = 0; i < 32; ++i) { up[(size_t)(c0 + i) * 131072] = f2bf(st); st = st * dc[i] + u[i]; }
#pragma unroll
            for (int i = 0; i < 32; ++i) { u[i] = un[i]; dc[i] = dn[i]; }
        }
    }
}
__device__ __forceinline__ void gla_passC(CParams& p, LAS unsigned char* lds, int j, int wv) {
    const int tid = opaque_tid(wv), wid = __builtin_amdgcn_readfirstlane(tid >> 6), lane = tid & 63, c = lane & 31, hi = lane >> 5;
    LAS bf16_t* vTl = (LAS bf16_t*)lds; LAS bf16_t* at = (LAS bf16_t*)(lds + 256 * TROW * 2); LAS float* red = (LAS float*)(lds + (256 + 64) * TROW * 2);
    const bf16_t* hg = (const bf16_t*)(p.ws + R_HG); const bf16_t* Sb = (const bf16_t*)(p.ws + R_U); bf16_t* y = (bf16_t*)(p.ws + R_Y);
    const float* gn = p.gla_g_norm + j * 256;
    for (int item = blockIdx.x; item < 1024; item += gridDim.x) {
        const int ch = item >> 2, h = item & 3;
        stage_vT(vTl, hg, ch, h, wv);
        if (wid < 3) {
            const int tb = wid == 0 ? 0 : 1, sb = wid == 2 ? 1 : 0; f32x16 a = zero16();
#pragma unroll
            for (int s = 0; s < 8; ++s) {
                const bf16x8 qf = *(const bf16x8*)(hg + (size_t)(64 * ch + 32 * tb + c) * 3072 + 128 * h + 16 * s + 8 * hi);
                const bf16x8 kf = *(const bf16x8*)(hg + (size_t)(64 * ch + 32 * sb + c) * 3072 + 512 + 128 * h + 16 * s + 8 * hi);
                a = mfma32(qf, kf, a);
            }
#pragma unroll
            for (int r = 0; r < 16; ++r) { const int t = crow(r, hi); float v = a[r]; if (tb == sb && c > t) v = 0.f; at[(32 * tb + t) * TROW + 32 * sb + c] = f2bf(v); }
        } else if (wid == 3) {
#pragma unroll
            for (int r = 0; r < 16; ++r) at[crow(r, hi) * TROW + 32 + c] = 0;
        }
        __syncthreads();
        f32x16 o[2]; o[0] = zero16(); o[1] = zero16();
        const bf16_t* sp = Sb + ((size_t)item * 256 + 32 * wid + c) * 128 + 8 * hi;
#pragma unroll
        for (int s = 0; s < 8; ++s) {
            const bf16x8 sf = *(const bf16x8*)(sp + 16 * s);
#pragma unroll
            for (int tb = 0; tb < 2; ++tb) { const bf16x8 qf = *(const bf16x8*)(hg + (size_t)(64 * ch + 32 * tb + c) * 3072 + 128 * h + 16 * s + 8 * hi); o[tb] = mfma32(sf, qf, o[tb]); }
        }
#pragma unroll
        for (int s = 0; s < 4; ++s) {
            const bf16x8 vf = *(const LAS bf16x8*)(vTl + (32 * wid + c) * TROW + (((2 * s + hi) ^ (((32 * wid + c) >> 3) & 7)) << 3));
#pragma unroll
            for (int tb = 0; tb < 2; ++tb) { const bf16x8 af = *(const LAS bf16x8*)(at + (32 * tb + c) * TROW + 16 * s + 8 * hi); o[tb] = mfma32(vf, af, o[tb]); }
        }
#pragma unroll
        for (int tb = 0; tb < 2; ++tb) { float ss = 0.f;
#pragma unroll
            for (int r = 0; r < 16; ++r) ss += o[tb][r] * o[tb][r];
            ss = xor32_sum(ss); if (hi == 0) red[wid * 64 + 32 * tb + c] = ss; }
        __syncthreads();
#pragma unroll
        for (int tb = 0; tb < 2; ++tb) {
            float tot = 0.f;
#pragma unroll
            for (int w8 = 0; w8 < 8; ++w8) tot += red[w8 * 64 + 32 * tb + c];
            const float rstd = rsqrtf(tot * (1.0f / 256.0f) + EPS); const size_t tok = (size_t)(64 * ch + 32 * tb + c);
#pragma unroll
            for (int g = 0; g < 4; ++g) {
                const int e0 = 32 * wid + 8 * g + 4 * hi;
                const s16x4 gv = *(const s16x4*)(hg + tok * 3072 + 2048 + 256 * h + e0); const f32x4 gg = *(const f32x4*)(gn + e0);
                float r4[4];
#pragma unroll
                for (int i = 0; i < 4; ++i) { const float gx = bf2f((bf16_t)gv[i]); const float sl = gx / (1.0f + expf(-gx)); r4[i] = o[tb][4 * g + i] * rstd * gg[i] * sl; }
                u32x2 wv; wv.x = cvt_pk_bf16(r4[0], r4[1]); wv.y = cvt_pk_bf16(r4[2], r4[3]); *(u32x2*)(y + tok * 1024 + 256 * h + e0) = wv;
            }
        }
        __syncthreads();
    }
}

#define XB_TMO      128
#define XB_XCNT(j)  (256  + 64 * (j))
#define XB_XSUB(j)  (1280 + 64 * (j))
#define XB_XGEN(j)  (2304 + 64 * (j))
#define XB_TOP      3328
#define XB_TOPGEN   3392
#define XCD_BAR_WORDS 3456
#define XB_SPIN_CAP (1u << 18)
__device__ __forceinline__ unsigned xb_ld(unsigned* p)              { return __hip_atomic_load(p, __ATOMIC_RELAXED, __HIP_MEMORY_SCOPE_AGENT); }
__device__ __forceinline__ unsigned xb_add(unsigned* p, unsigned v) { return __hip_atomic_fetch_add(p, v, __ATOMIC_RELAXED, __HIP_MEMORY_SCOPE_AGENT); }
__device__ __forceinline__ unsigned xb_xcc_id() { return (unsigned)__builtin_amdgcn_s_getreg((3 << 11) | 20) & 0xFu; }
#define XB_SPIN(cond, bar) do { unsigned _sp = 0; while (cond) { __builtin_amdgcn_s_sleep(1); \
    if ((++_sp & 255u) == 0u) { if (xb_ld(&(bar)[XB_TMO])) break; if (_sp > XB_SPIN_CAP) { atomicAdd(&(bar)[XB_TMO], 1u); break; } } } } while (0)
__device__ __forceinline__ void xcd_barrier_complete(unsigned* bar, unsigned x, unsigned& nloc, unsigned& nx) {
    const unsigned G = gridDim.x;
    unsigned sum, cnt, mine, sp = 0u;
    for (;;) {
        sum = 0u; cnt = 0u; mine = 0u;
#pragma unroll
        for (unsigned j = 0; j < 16; ++j) { const unsigned c = xb_ld(&bar[XB_XCNT(j)]); sum += c; cnt += (c > 0u) ? 1u : 0u; mine = (j == x) ? c : mine; }
        if (sum == G) break;
        __builtin_amdgcn_s_sleep(1);
        if ((++sp & 255u) == 0u) { if (xb_ld(&bar[XB_TMO])) break; if (sp > XB_SPIN_CAP) { atomicAdd(&bar[XB_TMO], 1u); break; } }
    }
    nloc = mine > 0u ? mine : 1u; nx = cnt > 0u ? cnt : 1u;
}
__device__ __forceinline__ void xcd_barrier(unsigned* bar, unsigned x, volatile LAS unsigned* st, int wv) {
    const int tid = opaque_tid(wv);
    asm volatile("s_waitcnt vmcnt(0)" ::: "memory");
    __syncthreads();
    if (tid == 0) {
        __builtin_amdgcn_s_waitcnt(0);
        unsigned nloc = st[0], nx = st[1];
        if (nloc == 0u) { xcd_barrier_complete(bar, x, nloc, nx); st[0] = nloc; st[1] = nx; }
        const unsigned old = xb_add(&bar[XB_XSUB(x)], 1u);
        const unsigned gen = old / nloc;
        if (old + 1u == (gen + 1u) * nloc) {
            __builtin_amdgcn_fence(__ATOMIC_RELEASE, "agent");
            asm volatile("s_waitcnt vmcnt(0)" ::: "memory");
            const unsigned og = xb_add(&bar[XB_TOP], 1u);
            const unsigned tg = og / nx;
            if (og + 1u == (tg + 1u) * nx) xb_add(&bar[XB_TOPGEN], 1u);
            else XB_SPIN(xb_ld(&bar[XB_TOPGEN]) == tg, bar);
            __builtin_amdgcn_fence(__ATOMIC_ACQUIRE, "agent");
            xb_add(&bar[XB_XGEN(x)], 1u);
            asm volatile("s_waitcnt vmcnt(0)" ::: "memory");
        } else {
            XB_SPIN(xb_ld(&bar[XB_XGEN(x)]) == gen, bar);
            __builtin_amdgcn_fence(__ATOMIC_ACQUIRE, "agent");
            asm volatile("s_waitcnt vmcnt(0)" ::: "memory");
        }
    }
    __syncthreads();
}
__global__ void __launch_bounds__(512) mk_fwd(Params p0) {
    extern __shared__ __attribute__((aligned(16))) unsigned char shm[];
    LAS unsigned char* lds = (LAS unsigned char*)shm;
    cg::grid_group grid = cg::this_grid();
    int ph = 0;
    const int wv = __builtin_amdgcn_readfirstlane((int)(threadIdx.x >> 6));
    if (p0.ph_lo < 0) grid.sync();
    volatile LAS unsigned* xst = (volatile LAS unsigned*)(lds + 132096);
    const unsigned xcc = xb_xcc_id();
    if (p0.ph_hi - p0.ph_lo > 1) {
        if (threadIdx.x == 0) { xst[0] = 0u; xst[1] = 0u; xb_add(&((unsigned*)(p0.ws + WS_BAR))[XB_XCNT(xcc)], 1u); }
        __syncthreads();
    }
    const int ph_lo = p0.ph_lo, ph_hi = p0.ph_hi;
#define hb ((bf16_t*)(p.ws + R_HB))
#define ssqkv ((float*)(p.ws + R_SSQKV))
#define ssqq ((float*)(p.ws + R_SSQQ))
#define qb ((bf16_t*)(p.ws + R_QB))
#define kn ((bf16_t*)(p.ws + R_KN))
#define vT ((bf16_t*)(p.ws + R_VT))
#define hg ((bf16_t*)(p.ws + R_HG))
#define ab ((float*)(p.ws + R_AB))
#define PHASE_BEGIN if (ph >= ph_lo && ph < ph_hi) { CParams* kp_ = (CParams*)__builtin_amdgcn_kernarg_segment_ptr(); asm volatile("" : "+s"(kp_)); CParams& p = *kp_;
#define PHASE_END   if (ph + 1 < ph_hi) xcd_barrier((unsigned*)(p.ws + WS_BAR), xcc, xst, wv); } ++ph;
#define xb ((bf16_t*)(p.ws + WS_XB))
#define ssqx ((float*)(p.ws + WS_SSQX))
#define invf ((const float*)(p.ws + WS_INVF))
#define wm ((bf16_t*)(p.ws + WS_WMIX))
#define wl ((bf16_t*)(p.ws + WS_WMLP))
    PHASE_BEGIN
        prologue_x(p, wv); conv_mixer(p, lds, 0, wv);
    PHASE_END
    auto layer_body = [&](auto LC) __attribute__((always_inline)) {
        constexpr int layer = decltype(LC)::value;
        constexpr int j = layer >> 1;
        if ((layer & 1) == 0) {
            PHASE_BEGIN
                EpiRow<M_MLAIN> E{hb, 768, ssqx, 4, 1.0f / 1024.0f, ssqkv, ssqq, nullptr, p.pos, invf};
                run_gemm(lds, xb, 1024, wm + WM_IN, 1024, S, 768, 1024, E, 0, wv);
                conv_mlp_weighted(p, lds, layer, wv, 192);
            PHASE_END
            PHASE_BEGIN
                { EpiRow<M_PLAIN> E{qb, 1536, ssqq, 2, 1.0f / 384.0f, nullptr, nullptr, nullptr, p.pos, invf};
                  run_gemm(lds, hb + 256, 768, wm + WM_UQ, 384, S, 1536, 384, E, 0, wv); }
                { EpiRow<M_PLAIN> E{kn, 1024, ssqkv, 1, 1.0f / 256.0f, nullptr, nullptr, nullptr, nullptr, nullptr};
                  run_gemm(lds, hb, 768, wm + WM_UK, 256, S, 1024, 256, E, 128, wv); }
                { EpiVT E{vT, ssqkv, 1.0f / 256.0f};
                  run_gemm(lds, wm + WM_UV, 256, hb, 768, 1024, S, 256, E, 128, wv); }
            PHASE_END
            PHASE_BEGIN
                attn_phase(p, lds, wv);
            PHASE_END
        } else {
            PHASE_BEGIN
                EpiRow<M_GLAIN> E{hg, 3072, ssqx, 4, 1.0f / 1024.0f, nullptr, nullptr, ab, nullptr, nullptr};
                run_gemm(lds, xb, 1024, wm + WM_IN, 1024, S, 3072, 1024, E, 0, wv);
                gla_gate_proj(p, lds, wv);
                conv_mlp(p, lds, layer, wv);
            PHASE_END
            PHASE_BEGIN
                gla_passA(p, lds, j, wv);
            PHASE_END
            PHASE_BEGIN
                gla_scan(p, wv);
            PHASE_END
            PHASE_BEGIN
                gla_passC(p, lds, j, wv);
            PHASE_END
        }
        PHASE_BEGIN
            const bool mla = (layer & 1) == 0;
            EpiRes E{xb, ssqx};
            run_gemm(lds, (const bf16_t*)(p.ws + (mla ? R_OB : R_Y)), 1024, wm + (mla ? WM_O_MLA : WM_O_GLA), 1024, S, 1024, 1024, E, 0, wv);
        PHASE_END
        PHASE_BEGIN
            EpiRow<M_SQRELU> E{(bf16_t*)(p.ws + R_HID), 4096, ssqx, 4, 1.0f / 1024.0f, nullptr, nullptr, nullptr, nullptr, nullptr};
            run_gemm(lds, xb, 1024, wl, 1024, S, 4096, 1024, E, 0, wv);
            if (layer < 3) conv_mixer(p, lds, layer + 1, wv);
        PHASE_END
        PHASE_BEGIN
            EpiRes E{xb, ssqx};
            run_gemm(lds, (const bf16_t*)(p.ws + R_HID), 4096, wl + (size_t)DFF * D, 4096, S, 1024, 4096, E, 0, wv);
        PHASE_END
    };
    layer_body(std::integral_constant<int, 0>{}); layer_body(std::integral_constant<int, 1>{}); layer_body(std::integral_constant<int, 2>{}); layer_body(std::integral_constant<int, 3>{});
    PHASE_BEGIN
        final_norm(p, wv);
    PHASE_END
}
#undef xb
#undef ssqx
#undef invf
#undef wm
#undef wl
#undef hb
#undef ssqkv
#undef ssqq
#undef qb
#undef kn
#undef vT
#undef hg
#undef ab
constexpr int N_PHASES = 1 + 2 * (4 + 2) + 2 * (5 + 2) + 1;

extern "C" void kernel_launch(void* const* d_in, const int* in_sizes, int n_in, void* d_out, int out_size, void* d_ws, size_t ws_size, hipStream_t stream) {
    static int grid = 0;
    if (grid == 0) {
        if (n_in != 18 || out_size != S * D || ws_size < WS_END) { fprintf(stderr, "kernel_launch: unexpected shapes (n_in %d out %d ws %zu need %zu)\n", n_in, out_size, ws_size, (size_t)WS_END); grid = -1; return; }
        int dev = 0, cus = 0, per_cu = 0;
        hipGetDevice(&dev); hipDeviceGetAttribute(&cus, hipDeviceAttributeMultiprocessorCount, dev);
        if (hipFuncSetAttribute((const void*)mk_fwd, hipFuncAttributeMaxDynamicSharedMemorySize, LDS_BYTES) != hipSuccess) { fprintf(stderr, "kernel_launch: hipFuncSetAttribute failed\n"); grid = -1; return; }
        if (hipOccupancyMaxActiveBlocksPerMultiprocessor(&per_cu, (const void*)mk_fwd, NTHR, LDS_BYTES) != hipSuccess || per_cu < 1) { fprintf(stderr, "kernel_launch: occupancy query gave %d\n", per_cu); per_cu = 1; }
        (void)hipGetLastError();
        grid = cus * per_cu;
        fprintf(stderr, "kernel_launch: grid %d (cus %d x %d)\n", grid, cus, per_cu);
    }
    if (grid < 0) return;
    Params p{};
    p.x = (const float*)d_in[0]; p.pos = (const int*)d_in[1]; p.norm_mix = (const float*)d_in[2]; p.norm_mlp = (const float*)d_in[3];
    p.mla_w_in = (const float*)d_in[4]; p.mla_q_norm = (const float*)d_in[5]; p.mla_w_uq = (const float*)d_in[6]; p.mla_kv_norm = (const float*)d_in[7];
    p.mla_w_ukv = (const float*)d_in[8]; p.mla_w_o = (const float*)d_in[9];
    p.gla_w_in = (const float*)d_in[10]; p.gla_w_gk_up = (const float*)d_in[11]; p.gla_b_gk = (const float*)d_in[12]; p.gla_g_norm = (const float*)d_in[13]; p.gla_w_o = (const float*)d_in[14];
    p.mlp_w_up = (const float*)d_in[15]; p.mlp_w_down = (const float*)d_in[16]; p.final_norm = (const float*)d_in[17];
    p.out = (float*)d_out; p.ws = (unsigned char*)d_ws;
#if N_LAUNCH_MODE == 1
    p.ph_lo = 0; p.ph_hi = N_PHASES;
    if (hipMemsetAsync((char*)d_ws + WS_BAR, 0, XCD_BAR_WORDS * 4, stream) != hipSuccess) { fprintf(stderr, "kernel_launch: memset of barrier words failed\n"); return; }
    void* args[] = {&p};
    hipError_t e = hipLaunchCooperativeKernel((const void*)mk_fwd, dim3(grid), dim3(NTHR), args, LDS_BYTES, stream);
    if (e != hipSuccess) fprintf(stderr, "cooperative launch failed: %s (grid %d)\n", hipGetErrorString(e), grid);
#else
    for (int ph = 0; ph < N_PHASES; ++ph) { p.ph_lo = ph; p.ph_hi = ph + 1; hipLaunchKernelGGL(mk_fwd, dim3(grid), dim3(NTHR), LDS_BYTES, stream, p); }
#endif
}
```
